# Optimizing an MI355X kernel written in HIP

```python
import math
import jax, jax.numpy as jnp
from jax import lax
import numpy as np

D_MODEL = 2048
BATCH = 1
SEQ = 8192
DEPTH = 4

CHUNK = 64
QBLOCK = 128
ATT_WIDTH = D_MODEL // 2
DIFF_HEAD_DIM = 64
DIFF_V_DIM = 2 * DIFF_HEAD_DIM
DIFF_HEADS = ATT_WIDTH // DIFF_V_DIM
SSM_WIDTH = D_MODEL // 2
SSM_HEAD_DIM = 64
SSM_HEADS = SSM_WIDTH // SSM_HEAD_DIM
SSM_GROUPS = 2
SSM_STATE = 128
CONV_WIDTH = 4
XBC_WIDTH = SSM_WIDTH + 2 * SSM_GROUPS * SSM_STATE
EVEN_IN = 4 * ATT_WIDTH + SSM_WIDTH + XBC_WIDTH + SSM_HEADS
POOL_WINDOWS = (2, 4, 8, 16)
POOL_WIDTH = D_MODEL
POOL_NGROUPS = len(POOL_WINDOWS)
POOL_GROUP = POOL_WIDTH // POOL_NGROUPS
N_EVEN = (DEPTH + 1) // 2
N_ODD = DEPTH // 2
DEEPNORM_ALPHA = (2.0 * DEPTH) ** 0.25
DEEPNORM_BETA = (8.0 * DEPTH) ** -0.25
LN_EPS = 1e-5
RMS_EPS = 1e-5

kernel_name = "hybrid_diffattn_ssd_pool_deepnorm"

F32 = jnp.float32


def layer_norm(x, g, b):
    xf = x.astype(F32)
    mu = jnp.mean(xf, axis=-1, keepdims=True)
    var = jnp.mean(jnp.square(xf - mu), axis=-1, keepdims=True)
    return ((xf - mu) * lax.rsqrt(var + LN_EPS) * g.astype(F32) + b.astype(F32)).astype(x.dtype)


def rms_norm(x, g=None):
    xf = x.astype(F32)
    y = xf * lax.rsqrt(jnp.mean(jnp.square(xf), axis=-1, keepdims=True) + RMS_EPS)
    if g is not None:
        y = y * g.astype(F32)
    return y


def segsum(a):
    t = a.shape[-1]
    ar = jnp.broadcast_to(a[..., :, None], a.shape + (t,))
    ar = jnp.where(jnp.tril(jnp.ones((t, t), bool), -1), ar, 0.0)
    cs = jnp.cumsum(ar, axis=-2)
    return jnp.where(jnp.tril(jnp.ones((t, t), bool), 0), cs, -jnp.inf)


def diff_attention(q, k, v, lam):
    s = q.shape[1]
    scale = DIFF_HEAD_DIM ** -0.5
    qf, kf, vf = q.astype(F32), k.astype(F32), v.astype(F32)
    outs = []
    for i in range(s // QBLOCK):
        qs, qe = i * QBLOCK, (i + 1) * QBLOCK
        sc = jnp.einsum('bqhmd,bkhmd->bhmqk', qf[:, qs:qe], kf[:, :qe]) * scale
        q_chunk = (qs + jnp.arange(QBLOCK)) // CHUNK
        k_chunk = jnp.arange(qe) // CHUNK
        sc = jnp.where(k_chunk[None, :] <= q_chunk[:, None], sc, -jnp.inf)
        p = jax.nn.softmax(sc, axis=-1)
        attn = p[:, :, 0] - lam * p[:, :, 1]
        outs.append(jnp.einsum('bhqk,bkhe->bqhe', attn, vf[:, :qe]))
    return jnp.concatenate(outs, axis=1)


def causal_depthwise_conv(u, w, bias):
    c = u.shape[-1]
    taps = w.astype(u.dtype)[:, None, :]
    y = lax.conv_general_dilated(u, taps, window_strides=(1,), padding=[(CONV_WIDTH - 1, 0)],
                                 dimension_numbers=('NWC', 'WIO', 'NWC'), feature_group_count=c)
    return y + bias.astype(u.dtype)


def ssd_chunked(xdt, a_dt, b_h, c_h):
    bsz, s, h, p = xdt.shape
    n = b_h.shape[-1]
    nc = s // CHUNK
    x = xdt.reshape(bsz, nc, CHUNK, h, p)
    a = a_dt.reshape(bsz, nc, CHUNK, h).transpose(0, 3, 1, 2)
    bc = b_h.reshape(bsz, nc, CHUNK, h, n)
    cc = c_h.reshape(bsz, nc, CHUNK, h, n)
    a_cs = jnp.cumsum(a, axis=-1)
    decay = jnp.exp(segsum(a))
    scores = jnp.einsum('bclhn,bcshn->bhcls', cc, bc) * decay
    y_diag = jnp.einsum('bhcls,bcshp->bclhp', scores, x)
    decay_states = jnp.exp(a_cs[..., -1:] - a_cs)
    states = jnp.einsum('bclhn,bhcl,bclhp->bchpn', bc, decay_states, x)
    chunk_decay = jnp.exp(a_cs[..., -1])

    def step(carry, inp):
        st, dec = inp
        return carry * dec[..., None, None] + st, carry

    _, prev = lax.scan(step, jnp.zeros((bsz, h, p, n), F32),
                       (states.transpose(1, 0, 2, 3, 4), chunk_decay.transpose(2, 0, 1)))
    prev = prev.transpose(1, 0, 2, 3, 4)
    y_off = jnp.einsum('bclhn,bchpn,bhcl->bclhp', cc, prev, jnp.exp(a_cs))
    return (y_diag + y_off).reshape(bsz, s, h, p)


def even_mixer(x, w_in, conv_w, conv_b, dt_bias, a_log, d_skip, ssm_norm_g,
               lq1, lk1, lq2, lk2, subln_g, w_out, lam_init):
    bsz, s, _ = x.shape
    hcat = x @ w_in
    o1 = 4 * ATT_WIDTH + SSM_WIDTH
    q, k, v, g_att, z, xbc, dt_raw = jnp.split(
        hcat, [ATT_WIDTH, 2 * ATT_WIDTH, 3 * ATT_WIDTH, 4 * ATT_WIDTH, o1, o1 + XBC_WIDTH], axis=-1)
    lam = (jnp.exp(jnp.sum(lq1.astype(F32) * lk1.astype(F32)))
           - jnp.exp(jnp.sum(lq2.astype(F32) * lk2.astype(F32))) + lam_init)
    q = q.reshape(bsz, s, DIFF_HEADS, 2, DIFF_HEAD_DIM)
    k = k.reshape(bsz, s, DIFF_HEADS, 2, DIFF_HEAD_DIM)
    v = v.reshape(bsz, s, DIFF_HEADS, DIFF_V_DIM)
    o = rms_norm(diff_attention(q, k, v, lam), subln_g) * (1.0 - lam_init)
    y_att = o.reshape(bsz, s, ATT_WIDTH).astype(x.dtype) * jax.nn.silu(g_att)
    xbc = jax.nn.silu(causal_depthwise_conv(xbc, conv_w, conv_b))
    xs, bm, cm = jnp.split(xbc, [SSM_WIDTH, SSM_WIDTH + SSM_GROUPS * SSM_STATE], axis=-1)
    rep = SSM_HEADS // SSM_GROUPS
    xs = xs.reshape(bsz, s, SSM_HEADS, SSM_HEAD_DIM).astype(F32)
    bm = jnp.repeat(bm.reshape(bsz, s, SSM_GROUPS, SSM_STATE), rep, axis=2).astype(F32)
    cm = jnp.repeat(cm.reshape(bsz, s, SSM_GROUPS, SSM_STATE), rep, axis=2).astype(F32)
    dt = jax.nn.softplus(dt_raw.astype(F32) + dt_bias.astype(F32))
    a = -jnp.exp(a_log.astype(F32))
    y = ssd_chunked(xs * dt[..., None], a * dt, bm, cm) + d_skip.astype(F32)[:, None] * xs
    y = y.reshape(bsz, s, SSM_WIDTH) * jax.nn.silu(z.astype(F32))
    y = rms_norm(y.reshape(bsz, s, SSM_GROUPS, SSM_WIDTH // SSM_GROUPS))
    y_ssm = (y.reshape(bsz, s, SSM_WIDTH) * ssm_norm_g.astype(F32)).astype(x.dtype)
    return jnp.concatenate([y_att, y_ssm], axis=-1) @ w_out


def pool_mixer(x, w_in, w_grp, b_grp, scale, w_out):
    bsz, s, _ = x.shape
    v, g = jnp.split(x @ w_in, [POOL_WIDTH], axis=-1)
    vf = v.astype(F32).reshape(bsz, s, POOL_NGROUPS, POOL_GROUP)
    cs = jnp.pad(jnp.cumsum(vf, axis=1), ((0, 0), (1, 0), (0, 0), (0, 0)))
    pos = jnp.arange(1, s + 1, dtype=F32)
    pooled = []
    for gi, w in enumerate(POOL_WINDOWS):
        c = cs[:, :, gi]
        lag = jnp.pad(c, ((0, 0), (w, 0), (0, 0)))[:, 1:s + 1]
        mean = (c[:, 1:] - lag) / jnp.minimum(pos, float(w))[None, :, None]
        pooled.append(mean - vf[:, :, gi])
    pooled = jnp.stack(pooled, axis=2).astype(x.dtype)
    m = jnp.einsum('bsgc,gcd->bsgd', pooled, w_grp) + b_grp
    y = m.reshape(bsz, s, POOL_WIDTH) * scale * jax.nn.silu(g)
    return y @ w_out


def setup_inputs(seed: int = 0) -> dict:
    key = jax.random.key(seed)
    ks = jax.random.split(key, 24)
    nrm = jax.random.normal
    dt0 = jnp.exp(jax.random.uniform(ks[4], (N_EVEN, SSM_HEADS), F32) * (math.log(0.1) - math.log(0.001))
                  + math.log(0.001))
    mix_w = ATT_WIDTH + SSM_WIDTH
    return {
        "x": nrm(ks[0], (BATCH, SEQ, D_MODEL), F32),
        "ev_w_in": nrm(ks[1], (N_EVEN, D_MODEL, EVEN_IN), F32) * D_MODEL ** -0.5,
        "ev_conv_w": nrm(ks[2], (N_EVEN, CONV_WIDTH, XBC_WIDTH), F32) * CONV_WIDTH ** -0.5,
        "ev_conv_b": 0.01 * nrm(ks[3], (N_EVEN, XBC_WIDTH), F32),
        "ev_dt_bias": dt0 + jnp.log(-jnp.expm1(-dt0)),
        "ev_a_log": jnp.log(jax.random.uniform(ks[5], (N_EVEN, SSM_HEADS), F32, 1.0, 16.0)),
        "ev_d_skip": 1.0 + 0.1 * nrm(ks[6], (N_EVEN, SSM_HEADS), F32),
        "ev_ssm_norm_g": 1.0 + 0.02 * nrm(ks[7], (N_EVEN, SSM_WIDTH), F32),
        "ev_lambda_q1": 0.1 * nrm(ks[8], (N_EVEN, DIFF_HEAD_DIM), F32),
        "ev_lambda_k1": 0.1 * nrm(ks[9], (N_EVEN, DIFF_HEAD_DIM), F32),
        "ev_lambda_q2": 0.1 * nrm(ks[10], (N_EVEN, DIFF_HEAD_DIM), F32),
        "ev_lambda_k2": 0.1 * nrm(ks[11], (N_EVEN, DIFF_HEAD_DIM), F32),
        "ev_subln_g": 1.0 + 0.02 * nrm(ks[12], (N_EVEN, DIFF_V_DIM), F32),
        "ev_w_out": nrm(ks[13], (N_EVEN, mix_w, D_MODEL), F32) * mix_w ** -0.5 * DEEPNORM_BETA,
        "od_w_in": nrm(ks[14], (N_ODD, D_MODEL, 2 * POOL_WIDTH), F32) * D_MODEL ** -0.5,
        "od_w_grp": nrm(ks[15], (N_ODD, POOL_NGROUPS, POOL_GROUP, POOL_GROUP), F32) * POOL_GROUP ** -0.5,
        "od_b_grp": 0.01 * nrm(ks[16], (N_ODD, POOL_NGROUPS, POOL_GROUP), F32),
        "od_scale": 1.0 + 0.02 * nrm(ks[17], (N_ODD, POOL_WIDTH), F32),
        "od_w_out": nrm(ks[18], (N_ODD, POOL_WIDTH, D_MODEL), F32) * POOL_WIDTH ** -0.5 * DEEPNORM_BETA,
        "ln_g": 1.0 + 0.02 * nrm(ks[19], (DEPTH, D_MODEL), F32),
        "ln_b": 0.02 * nrm(ks[20], (DEPTH, D_MODEL), F32),
    }


def reference(x, ev_w_in, ev_conv_w, ev_conv_b, ev_dt_bias, ev_a_log, ev_d_skip, ev_ssm_norm_g,
              ev_lambda_q1, ev_lambda_k1, ev_lambda_q2, ev_lambda_k2, ev_subln_g, ev_w_out,
              od_w_in, od_w_grp, od_b_grp, od_scale, od_w_out, ln_g, ln_b):
    for l in range(DEPTH):
        i = l // 2
        if l % 2 == 0:
            lam_init = 0.8 - 0.6 * math.exp(-0.3 * l)
            y = even_mixer(x, ev_w_in[i], ev_conv_w[i], ev_conv_b[i], ev_dt_bias[i], ev_a_log[i],
                           ev_d_skip[i], ev_ssm_norm_g[i], ev_lambda_q1[i], ev_lambda_k1[i],
                           ev_lambda_q2[i], ev_lambda_k2[i], ev_subln_g[i], ev_w_out[i], lam_init)
        else:
            y = pool_mixer(x, od_w_in[i], od_w_grp[i], od_b_grp[i], od_scale[i], od_w_out[i])
        x = layer_norm(DEEPNORM_ALPHA * x + y, ln_g[l], ln_b[l])
    return x
```

```cpp
#include <hip/hip_runtime.h>
#include <hip/hip_cooperative_groups.h>
#include <cstdio>
namespace cg = cooperative_groups;
#define DBG_SUB 0
#define PROBE_GEMM 0
#define PROBE_B 0
#define PROBE_SYNC 0
#define PROBE_CONV 0

typedef unsigned short bf16_t;
typedef short bf16x8 __attribute__((ext_vector_type(8)));
typedef short s16x4 __attribute__((ext_vector_type(4)));
typedef float f32x4 __attribute__((ext_vector_type(4)));
typedef unsigned u32x4 __attribute__((ext_vector_type(4)));
typedef unsigned u32x2 __attribute__((ext_vector_type(2)));

constexpr int S_ = 8192, D_ = 2048;
constexpr int EIN = 6672, EINP = 6784, HS = 6656;
constexpr int OHS = 4096;
constexpr int NCHUNK = 128;
constexpr float ALPHA = 1.6817928305074290f;
constexpr float LN_EPS = 1e-5f, RMS_EPS = 1e-5f;
constexpr int LDS_BYTES = 65536, LDS_TOTAL = LDS_BYTES + 16;

constexpr size_t SZ_WINE = (size_t)EINP * 2048 * 2, SZ_W2K = (size_t)2048 * 2048 * 2, SZ_WINO = (size_t)4096 * 2048 * 2, SZ_WGRP = (size_t)4 * 512 * 512 * 2;
constexpr size_t OFF_WINE = 0;
constexpr size_t OFF_WOUTE = OFF_WINE + 2 * SZ_WINE;
constexpr size_t OFF_WINO = OFF_WOUTE + 2 * SZ_W2K;
constexpr size_t OFF_WGRP = OFF_WINO + 2 * SZ_WINO;
constexpr size_t OFF_WOUTO = OFF_WGRP + 2 * SZ_WGRP;
constexpr size_t OFF_XB = OFF_WOUTO + 2 * SZ_W2K;
constexpr size_t OFF_H = OFF_XB + (size_t)S_ * D_ * 2;
constexpr size_t OFF_Y = OFF_H + (size_t)S_ * HS * 2;
constexpr size_t OFF_YS = OFF_Y + (size_t)S_ * D_ * 2;
constexpr size_t OFF_ST = OFF_YS + (size_t)S_ * 1024 * 4;
constexpr size_t OFF_DT = OFF_ST + (size_t)NCHUNK * 16 * 64 * 128 * 4;
constexpr size_t OFF_ACS = OFF_DT + (size_t)S_ * 16 * 4;
constexpr size_t OFF_CC = OFF_ACS + (size_t)S_ * 16 * 4;
constexpr size_t OFF_END = OFF_CC + (size_t)S_ * 256 * 2;
constexpr size_t OFF_BAR = OFF_END;
constexpr size_t OFF_STATS = OFF_BAR + 16384;
constexpr size_t OFF_DEC = OFF_STATS + (size_t)S_ * 2 * 4;
constexpr size_t OFF_END2 = OFF_DEC + (size_t)NCHUNK * 16 * 4;
constexpr size_t OFF_POOL = OFF_ST;
constexpr size_t OFF_T = OFF_ST + (size_t)NCHUNK * 16 * 64 * 128 * 2;

struct Params {
  const float* x; const float* ev_w_in; const float* ev_conv_w; const float* ev_conv_b; const float* ev_dt_bias;
  const float* ev_a_log; const float* ev_d_skip; const float* ev_ssm_norm_g; const float* lq1; const float* lk1;
  const float* lq2; const float* lk2; const float* subln_g; const float* ev_w_out; const float* od_w_in;
  const float* od_w_grp; const float* od_b_grp; const float* od_scale; const float* od_w_out; const float* ln_g;
  const float* ln_b; float* out; char* ws;
};

typedef __bf16 bf16x2_t __attribute__((ext_vector_type(2)));
typedef float f32x2_t __attribute__((ext_vector_type(2)));
__device__ __forceinline__ unsigned pk_bf16(float lo, float hi) { f32x2_t v = {lo, hi}; bf16x2_t b = __builtin_convertvector(v, bf16x2_t); return __builtin_bit_cast(unsigned, b); }
__device__ __forceinline__ u32x4 pk8_bf16(f32x4 a, f32x4 b) { u32x4 o; o[0] = pk_bf16(a[0], a[1]); o[1] = pk_bf16(a[2], a[3]); o[2] = pk_bf16(b[0], b[1]); o[3] = pk_bf16(b[2], b[3]); return o; }
__device__ __forceinline__ bf16_t f2bf(float f) { return (bf16_t)(pk_bf16(f, 0.f) & 0xffffu); }
__device__ __forceinline__ float bf2f(unsigned v) { return __uint_as_float(v << 16); }
__device__ __forceinline__ float bflo(unsigned v) { return __uint_as_float(v << 16); }
__device__ __forceinline__ float bfhi(unsigned v) { return __uint_as_float(v & 0xffff0000u); }
typedef _Float16 h16x2_t __attribute__((ext_vector_type(2)));
__device__ __forceinline__ unsigned pk_f16(float lo, float hi) { f32x2_t v = {lo, hi}; h16x2_t h = __builtin_convertvector(v, h16x2_t); return __builtin_bit_cast(unsigned, h); }
__device__ __forceinline__ f32x2_t up_f16(unsigned u) { h16x2_t h = __builtin_bit_cast(h16x2_t, u); return __builtin_convertvector(h, f32x2_t); }
__device__ __forceinline__ float silu_f(float x) { return x / (1.f + __expf(-x)); }
__device__ __forceinline__ float softplus_f(float x) { return fmaxf(x, 0.f) + log1pf(__expf(-fabsf(x))); }
__device__ __forceinline__ f32x4 mfma16(bf16x8 a, bf16x8 b, f32x4 c) { return __builtin_amdgcn_mfma_f32_16x16x32_bf16(a, b, c, 0, 0, 0); }
__device__ __forceinline__ bf16x8 lds_b128(const char* p) { return *(const bf16x8*)p; }
__device__ __forceinline__ unsigned lds_wave_addr(char* smem, int off) { return (unsigned)__builtin_amdgcn_readfirstlane((int)(unsigned)(size_t)(__attribute__((address_space(3))) char*)smem + off); }
#define LDS_PTR(U32) ((__attribute__((address_space(3))) void*)(size_t)(U32))
__device__ __forceinline__ float xmax16(float v) { const unsigned u = __float_as_uint(v); const u32x2 r = __builtin_amdgcn_permlane16_swap(u, u, false, false); return fmaxf(__uint_as_float(r[0]), __uint_as_float(r[1])); }
__device__ __forceinline__ float xmax32(float v) { const unsigned u = __float_as_uint(v); const u32x2 r = __builtin_amdgcn_permlane32_swap(u, u, false, false); return fmaxf(__uint_as_float(r[0]), __uint_as_float(r[1])); }
__device__ __forceinline__ int opaque_tid() { int t = threadIdx.x; asm volatile("" : "+v"(t)); return t; }

__device__ __forceinline__ void transpose_tiles(const float* __restrict__ W, bf16_t* __restrict__ Wt, int K, int N, int Npad, int nmat,
                                                size_t src_stride, size_t dst_stride, char* smem) {
  float* tile = (float*)smem;
  const int tid = opaque_tid();
  const int tk = K / 64, tn = Npad / 64, per = tk * tn, total = per * nmat;
  for (int t = blockIdx.x; t < total; t += gridDim.x) {
    const int mat = t / per, r = t % per, kt = r / tn, nt = r % tn;
    const float* src = W + (size_t)mat * src_stride;
    bf16_t* dst = Wt + (size_t)mat * dst_stride;
    const int k0 = kt * 64, n0 = nt * 64;
    __syncthreads();
#pragma unroll
    for (int i = 0; i < 4; ++i) {
      const int rr = (tid >> 4) + 16 * i, c4 = (tid & 15) * 4;
      f32x4 v = {0.f, 0.f, 0.f, 0.f};
      if (n0 + c4 < N) v = *(const f32x4*)(src + (size_t)(k0 + rr) * N + n0 + c4);
      tile[rr * 65 + c4 + 0] = v[0]; tile[rr * 65 + c4 + 1] = v[1]; tile[rr * 65 + c4 + 2] = v[2]; tile[rr * 65 + c4 + 3] = v[3];
    }
    __syncthreads();
#pragma unroll
    for (int j = 0; j < 2; ++j) {
      const int n = (tid >> 3) + 32 * j, kc = (tid & 7) * 8;
      u32x4 o;
      o[0] = pk_bf16(tile[(kc + 0) * 65 + n], tile[(kc + 1) * 65 + n]);
      o[1] = pk_bf16(tile[(kc + 2) * 65 + n], tile[(kc + 3) * 65 + n]);
      o[2] = pk_bf16(tile[(kc + 4) * 65 + n], tile[(kc + 5) * 65 + n]);
      o[3] = pk_bf16(tile[(kc + 6) * 65 + n], tile[(kc + 7) * 65 + n]);
      *(u32x4*)(dst + (size_t)(n0 + n) * K + k0 + kc) = o;
    }
  }
}

__device__ __forceinline__ void phase_convert(const Params& p, char* smem) {
  char* ws = p.ws;
  transpose_tiles(p.ev_w_in, (bf16_t*)(ws + OFF_WINE), 2048, EIN, EINP, 2, (size_t)2048 * EIN, (size_t)EINP * 2048, smem);
  transpose_tiles(p.ev_w_out, (bf16_t*)(ws + OFF_WOUTE), 2048, 2048, 2048, 2, (size_t)2048 * 2048, (size_t)2048 * 2048, smem);
  transpose_tiles(p.od_w_in, (bf16_t*)(ws + OFF_WINO), 2048, 4096, 4096, 2, (size_t)2048 * 4096, (size_t)4096 * 2048, smem);
  transpose_tiles(p.od_w_grp, (bf16_t*)(ws + OFF_WGRP), 512, 512, 512, 8, (size_t)512 * 512, (size_t)512 * 512, smem);
  transpose_tiles(p.od_w_out, (bf16_t*)(ws + OFF_WOUTO), 2048, 2048, 2048, 2, (size_t)2048 * 2048, (size_t)2048 * 2048, smem);
  bf16_t* xb = (bf16_t*)(ws + OFF_XB);
  const size_t n4 = (size_t)S_ * D_ / 4;
  for (size_t i = (size_t)blockIdx.x * 256 + opaque_tid(); i < n4; i += (size_t)gridDim.x * 256) {
    f32x4 v = *(const f32x4*)(p.x + i * 4);
    u32x2 o; o[0] = pk_bf16(v[0], v[1]); o[1] = pk_bf16(v[2], v[3]);
    *(u32x2*)(xb + i * 4) = o;
  }
}

template <bool GROUPED, class Epi>
__device__ __forceinline__ void gemm_phase(const bf16_t* __restrict__ A, int lda, const bf16_t* __restrict__ Bt, int ldb,
                                           int M, int N, int K, const Epi& epi, char* smem) {
  const int tid = opaque_tid(), lane = tid & 63, wave = tid >> 6, wr = wave >> 1, wc = wave & 1, fr = lane & 15, fq = lane >> 4;
  const int nM = M / 128, nN = N / 128, ntile = nM * nN, nkt = K / 64;
  const int G = gridDim.x;
  int vb = blockIdx.x;
  if ((G & 7) == 0) vb = (blockIdx.x & 7) * (G >> 3) + (blockIdx.x >> 3);
  const int lrow = tid >> 3, lch = tid & 7;
  const int prow = 8 * ((lrow & 15) >> 2) + 4 * (lrow >> 4) + (lrow & 3);
  const int st_off = lrow * 128 + ((lch ^ (lrow & 7)) << 4);
  const int swz = fr & 7;
  const int a_off = (wr * 64 + fr) * 128, b_off = 16384 + (wc * 64 + fr) * 128;
  const int c0 = ((fq ^ swz) << 4), c1 = (((4 | fq) ^ swz) << 4);
#define G_DMA(AG, BG, KT, BUF) _Pragma("unroll") for (int i = 0; i < 4; ++i) { \
      __builtin_amdgcn_global_load_lds((const __attribute__((address_space(1))) void*)((AG) + (size_t)(32 * i) * lda + (KT) * 64), LDS_PTR(ldsw + (BUF) * 32768 + i * 4096), 16, 0, 0); \
      __builtin_amdgcn_global_load_lds((const __attribute__((address_space(1))) void*)((BG) + (size_t)(32 * i) * ldb + (KT) * 64), LDS_PTR(ldsw + (BUF) * 32768 + 16384 + i * 4096), 16, 0, 0); }
    \
    \
#define G_COMPUTE(BUF) { const char* buf = smem + (BUF) * 32768; bf16x8 af[4], bfr[4], ag[4], bg[4]; \
      _Pragma("unroll") for (int j = 0; j < 4; ++j) { bfr[j] = lds_b128(buf + b_off + j * 2048 + c0); af[j] = lds_b128(buf + a_off + j * 2048 + c0); __builtin_amdgcn_sched_barrier(0); } \
      _Pragma("unroll") for (int q = 0; q < 4; ++q) { \
        _Pragma("unroll") for (int m = 0; m < q; ++m) acc[m][q] = mfma16(bfr[q], af[m], acc[m][q]); \
        _Pragma("unroll") for (int n = 0; n <= q; ++n) acc[q][n] = mfma16(bfr[n], af[q], acc[q][n]); \
        bg[q] = lds_b128(buf + b_off + q * 2048 + c1); ag[q] = lds_b128(buf + a_off + q * 2048 + c1); \
        __builtin_amdgcn_sched_barrier(0); } \
      _Pragma("unroll") for (int q = 0; q < 4; ++q) { \
        _Pragma("unroll") for (int m = 0; m < q; ++m) acc[m][q] = mfma16(bg[q], ag[m], acc[m][q]); \
        _Pragma("unroll") for (int n = 0; n <= q; ++n) acc[q][n] = mfma16(bg[n], ag[q], acc[q][n]); } }
#define G_TILE(T, PM, PN, AG, BG) { const int gid_ = (T) / (8 * nN), within_ = (T) % (8 * nN); PM = gid_ * 8 + (within_ & 7); PN = within_ >> 3; \
      AG = A + (size_t)(PM * 128 + lrow) * lda + ((lch ^ (lrow & 7)) * 8) + (GROUPED ? (PN >> 2) * 512 : 0); \
      BG = Bt + (size_t)(PN * 128 + prow) * ldb + ((lch ^ (lrow & 7)) * 8); }
  const unsigned ldsw = lds_wave_addr(smem, wave * 1024);
  int tile = vb, pm = 0, pn = 0;
  const bf16_t* Ag = A; const bf16_t* Bg = Bt;
  if (tile < ntile) {
    G_TILE(tile, pm, pn, Ag, Bg);
    __syncthreads();
    G_DMA(Ag, Bg, 0, 0);
  }
  while (tile < ntile) {
    f32x4 acc[4][4];
#pragma unroll
    for (int m = 0; m < 4; ++m)
#pragma unroll
      for (int n = 0; n < 4; ++n) acc[m][n] = (f32x4){0.f, 0.f, 0.f, 0.f};
    asm volatile("s_waitcnt vmcnt(0)" ::: "memory");
    __syncthreads();
    for (int kt = 0; kt < nkt; kt += 2) {
      G_DMA(Ag, Bg, kt + 1, 1);
      G_COMPUTE(0);
      asm volatile("s_waitcnt vmcnt(0)" ::: "memory");
      __syncthreads();
      if (kt + 2 < nkt) { G_DMA(Ag, Bg, kt + 2, 0); }
      G_COMPUTE(1);
      asm volatile("s_waitcnt vmcnt(0)" ::: "memory");
      __syncthreads();
    }
    const int tile_n = tile + G, pm_c = pm, pn_c = pn;
    if (tile_n < ntile) { G_TILE(tile_n, pm, pn, Ag, Bg); G_DMA(Ag, Bg, 0, 0); }
#pragma unroll
    for (int m = 0; m < 4; ++m)
#pragma unroll
      for (int gq = 0; gq < 2; ++gq) epi(pm_c * 128 + wr * 64 + m * 16 + fr, pn_c * 128 + wc * 64 + gq * 32 + fq * 8, acc[m][2 * gq], acc[m][2 * gq + 1]);
    tile = tile_n;
  }
#undef G_DMA
#undef G_COMPUTE
#undef G_TILE
}


struct EpiEvenIn {
  bf16_t* H; float* DT;
  __device__ __forceinline__ void operator()(int row, int col, f32x4 lo, f32x4 hi) const {
    if (col < HS) { *(u32x4*)(H + (size_t)row * HS + col) = pk8_bf16(lo, hi); }
    else if (col < EIN) { *(f32x4*)(DT + (size_t)row * 16 + (col - HS)) = lo; *(f32x4*)(DT + (size_t)row * 16 + (col - HS) + 4) = hi; }
  }
};
struct EpiOddIn {
  bf16_t* H;
  __device__ __forceinline__ void operator()(int row, int col, f32x4 lo, f32x4 hi) const { *(u32x4*)(H + (size_t)row * OHS + col) = pk8_bf16(lo, hi); }
};
struct EpiGrp {
  const bf16_t* H; const float* b; const float* sc; bf16_t* Y;
  __device__ __forceinline__ void operator()(int row, int col, f32x4 lo, f32x4 hi) const {
    const u32x4 g = *(const u32x4*)(H + (size_t)row * OHS + 2048 + col);
    f32x4 v[2] = {lo, hi};
#pragma unroll
    for (int q = 0; q < 2; ++q) {
      const f32x4 bb = *(const f32x4*)(b + col + 4 * q), ss = *(const f32x4*)(sc + col + 4 * q);
      v[q][0] = (v[q][0] + bb[0]) * ss[0] * silu_f(bflo(g[2 * q])); v[q][1] = (v[q][1] + bb[1]) * ss[1] * silu_f(bfhi(g[2 * q]));
      v[q][2] = (v[q][2] + bb[2]) * ss[2] * silu_f(bflo(g[2 * q + 1])); v[q][3] = (v[q][3] + bb[3]) * ss[3] * silu_f(bfhi(g[2 * q + 1]));
    }
    *(u32x4*)(Y + (size_t)row * D_ + col) = pk8_bf16(v[0], v[1]);
  }
};
struct EpiOut {
  const float* x0; const float* stats; const float* g; const float* b; bf16_t* T;
  __device__ __forceinline__ void operator()(int row, int col, f32x4 lo, f32x4 hi) const {
    f32x4 xp[2];
    if (stats) {
      const u32x4 t = *(const u32x4*)(T + (size_t)row * D_ + col);
      const float mu = stats[row * 2], rs = stats[row * 2 + 1];
#pragma unroll
      for (int q = 0; q < 2; ++q) {
        const f32x2_t t0 = up_f16(t[2 * q]), t1 = up_f16(t[2 * q + 1]);
        xp[q] = (f32x4){t0[0], t0[1], t1[0], t1[1]};
        xp[q] = (xp[q] - mu) * rs * *(const f32x4*)(g + col + 4 * q) + *(const f32x4*)(b + col + 4 * q);
      }
    } else {
      xp[0] = *(const f32x4*)(x0 + (size_t)row * D_ + col); xp[1] = *(const f32x4*)(x0 + (size_t)row * D_ + col + 4);
    }
    const f32x4 o0 = xp[0] * ALPHA + lo, o1 = xp[1] * ALPHA + hi;
    u32x4 ob; ob[0] = pk_f16(o0[0], o0[1]); ob[1] = pk_f16(o0[2], o0[3]); ob[2] = pk_f16(o1[0], o1[1]); ob[3] = pk_f16(o1[2], o1[3]);
    *(u32x4*)(T + (size_t)row * D_ + col) = ob;
  }
};

__device__ __forceinline__ void phase_ln(const bf16_t* T, float* X, bf16_t* XB, const float* __restrict__ g, const float* __restrict__ b, float* stats, bool write_x) {
  const int tidx = opaque_tid(); const int lane = tidx & 63, gw = blockIdx.x * 4 + (tidx >> 6), nw = gridDim.x * 4;
  for (int row0 = gw; row0 < S_; row0 += 2 * nw) {
    u32x4 raw[2][4];
#pragma unroll
    for (int rr = 0; rr < 2; ++rr) {
      const int row = row0 + rr * nw;
#pragma unroll
      for (int j = 0; j < 4; ++j) { raw[rr][j] = (u32x4){0u, 0u, 0u, 0u}; if (row < S_) raw[rr][j] = *(const u32x4*)(T + (size_t)row * D_ + j * 512 + lane * 8); }
    }
#pragma unroll
    for (int rr = 0; rr < 2; ++rr) {
      const int row = row0 + rr * nw;
      if (row < S_) {
        f32x4 v[8];
        float s = 0.f;
#pragma unroll
        for (int j = 0; j < 4; ++j) {
          const u32x4 t = raw[rr][j];
          const f32x2_t t0 = up_f16(t[0]), t1 = up_f16(t[1]), t2 = up_f16(t[2]), t3 = up_f16(t[3]);
          v[2 * j] = (f32x4){t0[0], t0[1], t1[0], t1[1]}; v[2 * j + 1] = (f32x4){t2[0], t2[1], t3[0], t3[1]};
          s += (v[2 * j][0] + v[2 * j][1] + v[2 * j][2] + v[2 * j][3]) + (v[2 * j + 1][0] + v[2 * j + 1][1] + v[2 * j + 1][2] + v[2 * j + 1][3]);
        }
#pragma unroll
        for (int o = 32; o >= 1; o >>= 1) s += __shfl_xor(s, o);
        const float mu = s * (1.f / D_);
        float q = 0.f;
#pragma unroll
        for (int j = 0; j < 8; ++j) { f32x4 d = v[j] - mu; q += d[0] * d[0] + d[1] * d[1] + d[2] * d[2] + d[3] * d[3]; }
#pragma unroll
        for (int o = 32; o >= 1; o >>= 1) q += __shfl_xor(q, o);
        const float rs = rsqrtf(q * (1.f / D_) + LN_EPS);
        if (lane == 0) { stats[row * 2] = mu; stats[row * 2 + 1] = rs; }
#pragma unroll
        for (int j = 0; j < 4; ++j) {
          const int c = j * 512 + lane * 8;
          const f32x4 o0 = (v[2 * j] - mu) * rs * *(const f32x4*)(g + c) + *(const f32x4*)(b + c);
          const f32x4 o1 = (v[2 * j + 1] - mu) * rs * *(const f32x4*)(g + c + 4) + *(const f32x4*)(b + c + 4);
          if (write_x) { *(f32x4*)(X + (size_t)row * D_ + c) = o0; *(f32x4*)(X + (size_t)row * D_ + c + 4) = o1; }
          *(u32x4*)(XB + (size_t)row * D_ + c) = pk8_bf16(o0, o1);
        }
      }
    }
  }
}

__device__ __forceinline__ void phase_pool(const bf16_t* __restrict__ H, bf16_t* __restrict__ P) {
  const int nitem = 256 * 512;
  for (int it = blockIdx.x * 256 + opaque_tid(); it < nitem; it += gridDim.x * 256) {
    const int c8 = it & 255, seg = it >> 8, w = 2 << (c8 >> 6), t0 = seg * 16;
    const bf16_t* col = H + c8 * 8;
    u32x4 r[31];
#pragma unroll
    for (int i = 0; i < 31; ++i) {
      const int t = t0 - 15 + i;
      r[i] = (u32x4){0u, 0u, 0u, 0u};
      if (t >= 0 && i >= 16 - w) r[i] = *(const u32x4*)(col + (size_t)t * OHS);
    }
    float sum[8];
#pragma unroll
    for (int j = 0; j < 8; ++j) sum[j] = 0.f;
#pragma unroll
    for (int i = 0; i < 15; ++i)
#pragma unroll
      for (int j = 0; j < 4; ++j) { sum[2 * j] += bflo(r[i][j]); sum[2 * j + 1] += bfhi(r[i][j]); }
#pragma unroll
    for (int q = 0; q < 16; ++q) {
      const int t = t0 + q;
      const u32x4 v = r[15 + q];
      float cur[8];
#pragma unroll
      for (int j = 0; j < 4; ++j) { cur[2 * j] = bflo(v[j]); cur[2 * j + 1] = bfhi(v[j]); }
#pragma unroll
      for (int j = 0; j < 8; ++j) sum[j] += cur[j];
      const float inv = 1.f / (float)min(t + 1, w);
      u32x4 o;
#pragma unroll
      for (int j = 0; j < 4; ++j) o[j] = pk_bf16(sum[2 * j] * inv - cur[2 * j], sum[2 * j + 1] * inv - cur[2 * j + 1]);
      *(u32x4*)(P + (size_t)t * D_ + c8 * 8) = o;
      const u32x4 u = (w == 16) ? r[q] : (w == 8) ? r[q + 8] : (w == 4) ? r[q + 12] : r[q + 14];
#pragma unroll
      for (int j = 0; j < 4; ++j) { sum[2 * j] -= bflo(u[j]); sum[2 * j + 1] -= bfhi(u[j]); }
    }
  }
}

__device__ __forceinline__ void attn_item1(const bf16_t* __restrict__ H, bf16_t* __restrict__ Y, const float* __restrict__ subln, float lam, float outscale,
                                           int head, int chunk, char* smem) {
  const int tid = opaque_tid(), lane = tid & 63, wave = tid >> 6, fr = lane & 15, fq = lane >> 4;
  const float cs = 0.125f * 1.4426950408889634f;
  const int ntiles = chunk + 1;
  const size_t qrow = (size_t)chunk * 64 + wave * 16 + fr;
  bf16x8 Qf[2][2];
#pragma unroll
  for (int hf = 0; hf < 2; ++hf)
#pragma unroll
    for (int ks = 0; ks < 2; ++ks) Qf[hf][ks] = *(const bf16x8*)(H + qrow * HS + head * 128 + hf * 64 + ks * 32 + fq * 8);
  const bf16_t* Kg = H + 1024 + head * 128;
  const bf16_t* Vg = H + 2048 + head * 128;
  const int pfr = (fr & 3) | ((fr & 4) << 1) | ((fr & 8) >> 1);
  int koff[4];
#pragma unroll
  for (int a = 0; a < 4; ++a) koff[a] = pfr * 256 + (((a * 4) ^ (pfr & 12)) << 4) + ((fq ^ (pfr & 3)) << 4);
  const int ld_row = tid >> 4, ld_ch = tid & 15;
  const unsigned kld_off = (unsigned)((ld_row * HS + ((ld_ch ^ ld_row) * 8)) * 2);
  const unsigned vld_off = (unsigned)((ld_row * HS + ((ld_ch ^ (((ld_row & 3) << 2) | ((ld_row >> 2) & 3))) * 8)) * 2);
#define A1_DMA(GBASE, OFF, LDSBASE) _Pragma("unroll") for (int i = 0; i < 4; ++i) \
    __builtin_amdgcn_global_load_lds((const __attribute__((address_space(1))) void*)((GBASE) + (size_t)i * (16 * HS * 2) + (OFF)), LDS_PTR(ldsw + (LDSBASE) + i * 4096), 16, 0, 0)
  const unsigned ldsw = lds_wave_addr(smem, wave * 1024);
  const int gl = lane & 15, tq = gl >> 2, tp = gl & 3;
  const int pq = ((fq & 1) << 1) | (fq >> 1);
  const int v_row = pq * 4 + tq;
  const int v_x = (tq << 2) | pq, v_hi = tp >> 1, v_lo = (tp & 1) * 8;
  float mx[2] = {-INFINITY, -INFINITY}, ls[2] = {0.f, 0.f};
  f32x4 O[2][8];
#pragma unroll
  for (int hf = 0; hf < 2; ++hf)
#pragma unroll
    for (int eb = 0; eb < 8; ++eb) O[hf][eb] = (f32x4){0.f, 0.f, 0.f, 0.f};
  __syncthreads();
  A1_DMA((const char*)Kg, kld_off, 0);
  A1_DMA((const char*)Vg, vld_off, 32768);
  for (int t = 0; t < ntiles; ++t) {
    asm volatile("s_waitcnt vmcnt(0)" ::: "memory");
    __builtin_amdgcn_s_barrier();
    asm volatile("" ::: "memory");
    if (t + 1 < ntiles) {
      A1_DMA((const char*)(Kg + (size_t)((t + 1) * 64) * HS), kld_off, ((t + 1) & 1) * 16384);
      A1_DMA((const char*)(Vg + (size_t)((t + 1) * 64) * HS), vld_off, 32768 + ((t + 1) & 1) * 16384);
    }
    const char* Kb = smem + (t & 1) * 16384;
    const char* Vb = smem + 32768 + (t & 1) * 16384;
    bf16x8 Pf[2][2];
    bf16x8 kf[2][4][2];
#pragma unroll
    for (int hf = 0; hf < 2; ++hf)
#pragma unroll
      for (int kb = 0; kb < 4; ++kb)
#pragma unroll
        for (int ks = 0; ks < 2; ++ks) kf[hf][kb][ks] = lds_b128(Kb + koff[hf * 2 + ks] + kb * 4096);
    __builtin_amdgcn_sched_group_barrier(0x100, 16, 0);
    f32x4 Sx[2][4];
    float mn[2];
#pragma unroll
    for (int hf = 0; hf < 2; ++hf) {
#pragma unroll
      for (int kb = 0; kb < 4; ++kb) Sx[hf][kb] = (f32x4){0.f, 0.f, 0.f, 0.f};
#pragma unroll
      for (int kb = 0; kb < 4; ++kb)
#pragma unroll
        for (int ks = 0; ks < 2; ++ks) Sx[hf][kb] = mfma16(kf[hf][kb][ks], Qf[hf][ks], Sx[hf][kb]);
    }
#pragma unroll
    for (int hf = 0; hf < 2; ++hf) {
      float tm = -INFINITY;
#pragma unroll
      for (int kb = 0; kb < 4; ++kb)
#pragma unroll
        for (int r = 0; r < 4; ++r) tm = fmaxf(tm, Sx[hf][kb][r]);
      tm = xmax16(tm); tm = xmax32(tm);
      mn[hf] = fmaxf(mx[hf], tm * cs);
    }
    if (__builtin_amdgcn_ballot_w64((mn[0] > mx[0] + 8.0f) || (mn[1] > mx[1] + 8.0f)) != 0ull) {
#pragma unroll
      for (int hf = 0; hf < 2; ++hf) {
        const float alpha = __builtin_amdgcn_exp2f(mx[hf] - mn[hf]);
        ls[hf] *= alpha;
#pragma unroll
        for (int eb = 0; eb < 8; ++eb) O[hf][eb] *= alpha;
        mx[hf] = mn[hf];
      }
    }
#pragma unroll
    for (int hf = 0; hf < 2; ++hf) {
      float pv[16], sum = 0.f;
#pragma unroll
      for (int kb = 0; kb < 4; ++kb)
#pragma unroll
        for (int r = 0; r < 4; ++r) { pv[kb * 4 + r] = __builtin_amdgcn_exp2f(Sx[hf][kb][r] * cs - mx[hf]); sum += pv[kb * 4 + r]; }
      ls[hf] += sum;
#pragma unroll
      for (int ks2 = 0; ks2 < 2; ++ks2) {
        u32x4 pk;
        pk[0] = pk_bf16(pv[(2 * ks2) * 4 + 0], pv[(2 * ks2) * 4 + 1]); pk[1] = pk_bf16(pv[(2 * ks2) * 4 + 2], pv[(2 * ks2) * 4 + 3]);
        pk[2] = pk_bf16(pv[(2 * ks2 + 1) * 4 + 0], pv[(2 * ks2 + 1) * 4 + 1]); pk[3] = pk_bf16(pv[(2 * ks2 + 1) * 4 + 2], pv[(2 * ks2 + 1) * 4 + 3]);
        Pf[hf][ks2] = __builtin_bit_cast(bf16x8, pk);
      }
    }
#pragma unroll
    for (int eh = 0; eh < 2; ++eh) {
      s16x4 va[4][2], vb[4][2];
#pragma unroll
      for (int e4 = 0; e4 < 4; ++e4)
#pragma unroll
        for (int ks2 = 0; ks2 < 2; ++ks2) {
          const int eb = eh * 4 + e4;
          const int cho = (((2 * eb + v_hi) ^ v_x) << 4) + v_lo;
          const int ra = v_row + (2 * ks2) * 16, rb = ra + 16;
          va[e4][ks2] = __builtin_amdgcn_ds_read_tr16_b64_v4i16((__attribute__((address_space(3))) s16x4*)(Vb + ra * 256 + cho));
          vb[e4][ks2] = __builtin_amdgcn_ds_read_tr16_b64_v4i16((__attribute__((address_space(3))) s16x4*)(Vb + rb * 256 + cho));
        }
#pragma unroll
      for (int e4 = 0; e4 < 4; ++e4)
#pragma unroll
        for (int ks2 = 0; ks2 < 2; ++ks2) {
          const int eb = eh * 4 + e4;
          bf16x8 vf; vf[0] = va[e4][ks2][0]; vf[1] = va[e4][ks2][1]; vf[2] = va[e4][ks2][2]; vf[3] = va[e4][ks2][3];
          vf[4] = vb[e4][ks2][0]; vf[5] = vb[e4][ks2][1]; vf[6] = vb[e4][ks2][2]; vf[7] = vb[e4][ks2][3];
          O[0][eb] = mfma16(vf, Pf[0][ks2], O[0][eb]);
          O[1][eb] = mfma16(vf, Pf[1][ks2], O[1][eb]);
        }
    }
    __builtin_amdgcn_sched_group_barrier(0x100, 16, 0);
#pragma unroll
    for (int g = 0; g < 4; ++g) { __builtin_amdgcn_sched_group_barrier(0x008, 4, 0); __builtin_amdgcn_sched_group_barrier(0x100, 4, 0); }
    __builtin_amdgcn_sched_group_barrier(0x008, 16, 0);
  }
#undef A1_DMA
  float l0 = ls[0], l1 = ls[1];
  l0 += __shfl_xor(l0, 16); l0 += __shfl_xor(l0, 32);
  l1 += __shfl_xor(l1, 16); l1 += __shfl_xor(l1, 32);
  const float i0 = 1.f / l0, i1 = lam / l1;
  float ss = 0.f;
#pragma unroll
  for (int eb = 0; eb < 8; ++eb) {
    O[0][eb] = O[0][eb] * i0 - O[1][eb] * i1;
    ss += O[0][eb][0] * O[0][eb][0] + O[0][eb][1] * O[0][eb][1] + O[0][eb][2] * O[0][eb][2] + O[0][eb][3] * O[0][eb][3];
  }
  ss += __shfl_xor(ss, 16); ss += __shfl_xor(ss, 32);
  const float rs = rsqrtf(ss * (1.f / 128.f) + RMS_EPS) * outscale;
#pragma unroll
  for (int eb = 0; eb < 8; ++eb) {
    const int e = eb * 16 + fq * 4;
    const f32x4 sg = *(const f32x4*)(subln + e);
    const u32x2 g = *(const u32x2*)(H + qrow * HS + 3072 + head * 128 + e);
    const float r0 = O[0][eb][0] * rs * sg[0] * silu_f(bflo(g[0])), r1 = O[0][eb][1] * rs * sg[1] * silu_f(bfhi(g[0]));
    const float r2 = O[0][eb][2] * rs * sg[2] * silu_f(bflo(g[1])), r3 = O[0][eb][3] * rs * sg[3] * silu_f(bfhi(g[1]));
    u32x2 o; o[0] = pk_bf16(r0, r1); o[1] = pk_bf16(r2, r3);
    *(u32x2*)(Y + qrow * D_ + head * 128 + e) = o;
  }
}

__device__ __forceinline__ f32x4 mma_lds(const bf16_t* X, int ldx, const bf16_t* Yp, int ldy, int K, int fr, int fq) {
  f32x4 acc = {0.f, 0.f, 0.f, 0.f};
  for (int k0 = 0; k0 < K; k0 += 32) {
    const bf16x8 a = *(const bf16x8*)(X + fr * ldx + k0 + fq * 8);
    const bf16x8 b = *(const bf16x8*)(Yp + fr * ldy + k0 + fq * 8);
    acc = mfma16(a, b, acc);
  }
  return acc;
}

constexpr int SSD_ACS = 0, SSD_DT = 2048, SSD_BT = 4096, SSD_G = SSD_BT + 128 * 72 * 2, SSD_R = SSD_G + 64 * 72 * 2;
constexpr int SSD_CS = SSD_R, SSD_BS = SSD_R + 64 * 128 * 2;
constexpr int SSD_XDT = SSD_R, SSD_XDEC = SSD_R + 9216, SSD_M = SSD_R + 18432;
static_assert(SSD_R + 27648 <= LDS_BYTES, "lds");
static_assert(SSD_BS + 64 * 128 * 2 <= LDS_BYTES, "lds");

__device__ __forceinline__ void ssd_item(const Params& p, int li, int chunk, int grp, int hbeg, char* smem) {
  const int tid = opaque_tid(), lane = tid & 63, wave = tid >> 6, fr = lane & 15, fq = lane >> 4;
  char* ws = p.ws;
  const bf16_t* H = (const bf16_t*)(ws + OFF_H);
  const float* DT = (const float*)(ws + OFF_DT);
  float* ACS = (float*)(ws + OFF_ACS);
  bf16_t* CC = (bf16_t*)(ws + OFF_CC);
  bf16_t* YS = (bf16_t*)(ws + OFF_YS);
  bf16_t* ST = (bf16_t*)(ws + OFF_ST);
  const float* conv_w = p.ev_conv_w + (size_t)li * 4 * 1536;
  const float* conv_b = p.ev_conv_b + (size_t)li * 1536;
  float* acs_s = (float*)(smem + SSD_ACS); float* dt_s = (float*)(smem + SSD_DT);
  bf16_t* BT = (bf16_t*)(smem + SSD_BT); bf16_t* Gs = (bf16_t*)(smem + SSD_G);
  bf16_t* Cs = (bf16_t*)(smem + SSD_CS); bf16_t* Bs = (bf16_t*)(smem + SSD_BS);
  bf16_t* xdtT = (bf16_t*)(smem + SSD_XDT); bf16_t* xdecT = (bf16_t*)(smem + SSD_XDEC); bf16_t* Ms = (bf16_t*)(smem + SSD_M);
  const int tok0 = chunk * 64;
  __syncthreads();
  {
    const int hh = hbeg + wave, h = grp * 8 + hh;
    const float dtv = softplus_f(DT[(size_t)(tok0 + lane) * 16 + h] + p.ev_dt_bias[li * 16 + h]);
    float a = -__expf(p.ev_a_log[li * 16 + h]) * dtv;
#pragma unroll
    for (int o = 1; o < 64; o <<= 1) { const float t = __shfl_up(a, o); if (lane >= o) a += t; }
    dt_s[hh * 64 + lane] = dtv; acs_s[hh * 64 + lane] = a;
    ACS[(size_t)(tok0 + lane) * 16 + h] = a;
    if (lane == 63) ((float*)(ws + OFF_DEC))[chunk * 16 + h] = __expf(a);
  }
  {
    const int cp = tid & 127, lseg = tid >> 7, j0 = cp * 2;
    const int isC = j0 >= 128, n0 = j0 & 127;
    const int xch = 1024 + (isC ? 256 : 0) + grp * 128 + n0;
    const bf16_t* src = H + 5120 + xch;
    float w0[4], w1[4];
#pragma unroll
    for (int j = 0; j < 4; ++j) { w0[j] = conv_w[j * 1536 + xch]; w1[j] = conv_w[j * 1536 + xch + 1]; }
    const float b0 = conv_b[xch], b1 = conv_b[xch + 1];
    float h0[3], h1[3];
#pragma unroll
    for (int j = 0; j < 3; ++j) {
      const int t = tok0 + lseg * 32 - 3 + j;
      unsigned v = 0; if (t >= 0) v = *(const unsigned*)(src + (size_t)t * HS);
      h0[j] = bflo(v); h1[j] = bfhi(v);
    }
    for (int l = lseg * 32; l < lseg * 32 + 32; ++l) {
      const unsigned v = *(const unsigned*)(src + (size_t)(tok0 + l) * HS);
      const float c0 = bflo(v), c1 = bfhi(v);
      const float y0 = silu_f(b0 + w0[0] * h0[0] + w0[1] * h0[1] + w0[2] * h0[2] + w0[3] * c0);
      const float y1 = silu_f(b1 + w1[0] * h1[0] + w1[1] * h1[1] + w1[2] * h1[2] + w1[3] * c1);
      h0[0] = h0[1]; h0[1] = h0[2]; h0[2] = c0; h1[0] = h1[1]; h1[1] = h1[2]; h1[2] = c1;
      const unsigned pk = pk_bf16(y0, y1);
      if (isC) { *(unsigned*)(Cs + l * 128 + n0) = pk; *(unsigned*)(CC + (size_t)(tok0 + l) * 256 + grp * 128 + n0) = pk; }
      else { *(unsigned*)(Bs + l * 128 + n0) = pk; BT[n0 * 72 + l] = (bf16_t)(pk & 0xffffu); BT[(n0 + 1) * 72 + l] = (bf16_t)(pk >> 16); }
    }
  }
  __syncthreads();
#pragma unroll
  for (int sb = 0; sb < 4; ++sb) {
    const f32x4 g = mma_lds(Cs + wave * 16 * 128, 128, Bs + sb * 16 * 128, 128, 128, fr, fq);
#pragma unroll
    for (int r = 0; r < 4; ++r) Gs[(wave * 16 + fq * 4 + r) * 72 + sb * 16 + fr] = f2bf(g[r]);
#if DBG_SUB == 3
    for (int r = 0; r < 4; ++r) YS[(size_t)(tok0 + wave * 16 + fq * 4 + r) * 1024 + grp * 512 + sb * 16 + fr] = g[r];
#endif
  }
  __syncthreads();
  for (int hh = hbeg; hh < hbeg + 4; ++hh) {
    const int h = grp * 8 + hh;
    const float* acs = acs_s + hh * 64; const float* dts = dt_s + hh * 64;
    const float acs_last = acs[63];
    {
      const int pp = tid & 31, lseg = tid >> 5, p0 = pp * 2;
      const int xch = grp * 512 + hh * 64 + p0;
      const bf16_t* src = H + 5120 + xch;
      float w0[4], w1[4];
#pragma unroll
      for (int j = 0; j < 4; ++j) { w0[j] = conv_w[j * 1536 + xch]; w1[j] = conv_w[j * 1536 + xch + 1]; }
      const float b0 = conv_b[xch], b1 = conv_b[xch + 1];
      float h0[3], h1[3];
#pragma unroll
      for (int j = 0; j < 3; ++j) {
        const int t = tok0 + lseg * 8 - 3 + j;
        unsigned v = 0; if (t >= 0) v = *(const unsigned*)(src + (size_t)t * HS);
        h0[j] = bflo(v); h1[j] = bfhi(v);
      }
#pragma unroll
      for (int q = 0; q < 8; ++q) {
        const int l = lseg * 8 + q;
        const unsigned v = *(const unsigned*)(src + (size_t)(tok0 + l) * HS);
        const float c0 = bflo(v), c1 = bfhi(v);
        const float y0 = silu_f(b0 + w0[0] * h0[0] + w0[1] * h0[1] + w0[2] * h0[2] + w0[3] * c0);
        const float y1 = silu_f(b1 + w1[0] * h1[0] + w1[1] * h1[1] + w1[2] * h1[2] + w1[3] * c1);
        h0[0] = h0[1]; h0[1] = h0[2]; h0[2] = c0; h1[0] = h1[1]; h1[1] = h1[2]; h1[2] = c1;
        const float dtl = dts[l], dec = __expf(acs_last - acs[l]);
        const unsigned a = pk_bf16(y0 * dtl, y1 * dtl), d = pk_bf16(y0 * dtl * dec, y1 * dtl * dec);
        xdtT[p0 * 72 + l] = (bf16_t)(a & 0xffffu); xdtT[(p0 + 1) * 72 + l] = (bf16_t)(a >> 16);
        xdecT[p0 * 72 + l] = (bf16_t)(d & 0xffffu); xdecT[(p0 + 1) * 72 + l] = (bf16_t)(d >> 16);
      }
      const int l = tid >> 2, s0 = (tid & 3) * 16;
      const float al = acs[l];
#pragma unroll
      for (int q = 0; q < 16; ++q) {
        const int s = s0 + q;
        const float v = (s <= l) ? bf2f(Gs[l * 72 + s]) * __expf(al - acs[s]) : 0.f;
        Ms[l * 72 + s] = f2bf(v);
      }
    }
    __syncthreads();
    {
      const float dsk = p.ev_d_skip[li * 16 + h];
      const int l = wave * 16 + fr;
      const float dskdt = dsk / fmaxf(dts[l], 1e-30f);
#pragma unroll
      for (int pb = 0; pb < 4; ++pb) {
        f32x4 d = mma_lds(xdtT + pb * 16 * 72, 72, Ms + wave * 16 * 72, 72, 64, fr, fq);
        const int pc = pb * 16 + fq * 4;
#pragma unroll
        for (int r = 0; r < 4; ++r) d[r] += dskdt * bf2f(xdtT[(pc + r) * 72 + l]);
#if DBG_SUB == 3
        if (hh > 100)
#endif
        { u32x2 yo; yo[0] = pk_bf16(d[0], d[1]); yo[1] = pk_bf16(d[2], d[3]); *(u32x2*)(YS + (size_t)(tok0 + l) * 1024 + grp * 512 + hh * 64 + pc) = yo; }
      }
#pragma unroll
      for (int nb = 0; nb < 8; ++nb) {
        const f32x4 d = mma_lds(BT + nb * 16 * 72, 72, xdecT + wave * 16 * 72, 72, 64, fr, fq);
        u32x2 sb; sb[0] = pk_bf16(d[0], d[1]); sb[1] = pk_bf16(d[2], d[3]);
        *(u32x2*)(ST + (((size_t)chunk * 16 + h) * 64 + wave * 16 + fr) * 128 + nb * 16 + fq * 4) = sb;
      }
    }
    __syncthreads();
  }
}

__device__ __forceinline__ void phase_scan(const Params& p) {
  unsigned* ST = (unsigned*)(p.ws + OFF_ST);
  const float* DEC = (const float*)(p.ws + OFF_DEC);
  for (int e2 = blockIdx.x * 256 + opaque_tid(); e2 < 16 * 64 * 128 / 2; e2 += gridDim.x * 256) {
    const int h = e2 >> 12;
    float c0 = 0.f, c1 = 0.f;
    for (int ch = 0; ch < NCHUNK; ch += 8) {
      unsigned sv[8]; float d[8];
#pragma unroll
      for (int j = 0; j < 8; ++j) { sv[j] = ST[(size_t)(ch + j) * 65536 + e2]; d[j] = DEC[(ch + j) * 16 + h]; }
#pragma unroll
      for (int j = 0; j < 8; ++j) {
        ST[(size_t)(ch + j) * 65536 + e2] = pk_bf16(c0, c1);
        const float dec = d[j];
        c0 = c0 * dec + bflo(sv[j]); c1 = c1 * dec + bfhi(sv[j]);
      }
    }
  }
}

__device__ __forceinline__ void ssd_out_item(const Params& p, int li, int chunk, int grp, int rh, char* smem) {
  const int tid = opaque_tid(), lane = tid & 63, wave = tid >> 6, fr = lane & 15, fq = lane >> 4;
  char* ws = p.ws;
  const bf16_t* H = (const bf16_t*)(ws + OFF_H);
  const float* ACS = (const float*)(ws + OFF_ACS);
  const bf16_t* CC = (const bf16_t*)(ws + OFF_CC);
  const bf16_t* YS = (const bf16_t*)(ws + OFF_YS);
  const bf16_t* ST = (const bf16_t*)(ws + OFF_ST);
  bf16_t* Y = (bf16_t*)(ws + OFF_Y);
  bf16_t* Cs = (bf16_t*)smem; bf16_t* Pv = (bf16_t*)(smem + 17408); float* rowss = (float*)(smem + 34816);
  const int tok0 = chunk * 64;
  __syncthreads();
#pragma unroll
  for (int i = 0; i < 4; ++i) {
    const int idx = tid + 256 * i, row = idx >> 4, ch = idx & 15;
    *(u32x4*)(Cs + row * 136 + ch * 8) = *(const u32x4*)(CC + (size_t)(tok0 + row) * 256 + grp * 128 + ch * 8);
  }
  if (tid < 64) rowss[tid] = 0.f;
  const int lb = rh * 2 + (wave & 1), pb0 = (wave >> 1) * 2;
  const int l = lb * 16 + fr;
  const size_t tok = (size_t)tok0 + l;
  float ss = 0.f;
  for (int hh = 0; hh < 8; ++hh) {
    const int h = grp * 8 + hh;
    __syncthreads();
    const bf16_t* src = ST + ((size_t)chunk * 16 + h) * 8192;
#pragma unroll
    for (int i = 0; i < 4; ++i) {
      const int idx = tid + 256 * i, row = idx >> 4, c8 = (idx & 15) * 8;
      *(u32x4*)(Pv + row * 136 + c8) = *(const u32x4*)(src + row * 128 + c8);
    }
    __syncthreads();
    const float ea = __expf(ACS[tok * 16 + h]);
#pragma unroll
    for (int pb = pb0; pb < pb0 + 2; ++pb) {
      const f32x4 d = mma_lds(Pv + pb * 16 * 136, 136, Cs + lb * 16 * 136, 136, 128, fr, fq);
      const int ch = grp * 512 + hh * 64 + pb * 16 + fq * 4;
      const u32x2 yi = *(const u32x2*)(YS + tok * 1024 + ch);
      f32x4 y = {bflo(yi[0]), bfhi(yi[0]), bflo(yi[1]), bfhi(yi[1])};
      const u32x2 z = *(const u32x2*)(H + tok * HS + 4096 + ch);
      y[0] = (y[0] + d[0] * ea) * silu_f(bflo(z[0])); y[1] = (y[1] + d[1] * ea) * silu_f(bfhi(z[0]));
      y[2] = (y[2] + d[2] * ea) * silu_f(bflo(z[1])); y[3] = (y[3] + d[3] * ea) * silu_f(bfhi(z[1]));
      { u32x2 yo; yo[0] = pk_bf16(y[0], y[1]); yo[1] = pk_bf16(y[2], y[3]); *(u32x2*)(Y + tok * D_ + 1024 + ch) = yo; }
      ss += y[0] * y[0] + y[1] * y[1] + y[2] * y[2] + y[3] * y[3];
    }
  }
  ss += __shfl_xor(ss, 16); ss += __shfl_xor(ss, 32);
  if (fq == 0) atomicAdd(&rowss[l], ss);
  __syncthreads();
  const float rs = rsqrtf(rowss[l] * (1.f / 512.f) + RMS_EPS);
  const float* ng = p.ev_ssm_norm_g + (size_t)li * 1024;
  for (int hh = 0; hh < 8; ++hh) {
#pragma unroll
    for (int pb = pb0; pb < pb0 + 2; ++pb) {
      const int ch = grp * 512 + hh * 64 + pb * 16 + fq * 4;
      const u32x2 yi = *(const u32x2*)(Y + tok * D_ + 1024 + ch);
      const f32x4 y = {bflo(yi[0]), bfhi(yi[0]), bflo(yi[1]), bfhi(yi[1])};
      const f32x4 g = *(const f32x4*)(ng + ch);
      u32x2 o; o[0] = pk_bf16(y[0] * rs * g[0], y[1] * rs * g[1]); o[1] = pk_bf16(y[2] * rs * g[2], y[3] * rs * g[3]);
      *(u32x2*)(Y + tok * D_ + 1024 + ch) = o;
    }
  }
}


#define XB_TMO      128
#define XB_XCNT(j)  (256  + 64 * (j))
#define XB_XSUB(j)  (1280 + 64 * (j))
#define XB_XGEN(j)  (2304 + 64 * (j))
#define XB_TOP      3328
#define XB_TOPGEN   3392
#define XCD_BAR_WORDS 3456
#define XB_SPIN_CAP (1u << 20)
#define LAS __attribute__((address_space(3)))
__device__ __forceinline__ unsigned xb_ld(unsigned* p)              { return __hip_atomic_load(p, __ATOMIC_RELAXED, __HIP_MEMORY_SCOPE_AGENT); }
__device__ __forceinline__ unsigned xb_add(unsigned* p, unsigned v) { return __hip_atomic_fetch_add(p, v, __ATOMIC_RELAXED, __HIP_MEMORY_SCOPE_AGENT); }
__device__ __forceinline__ unsigned xb_xcc_id() { return (unsigned)__builtin_amdgcn_s_getreg((3 << 11) | 20) & 0xFu; }
#define XB_SPIN(cond, bar) do { unsigned _sp = 0; while (cond) { __builtin_amdgcn_s_sleep(1); \
    if ((++_sp & 255u) == 0u) { if (xb_ld(&(bar)[XB_TMO])) break; if (_sp > XB_SPIN_CAP) { atomicAdd(&(bar)[XB_TMO], 1u); break; } } } } while (0)
struct XcdBarrier { unsigned* bar; unsigned x; volatile LAS unsigned* st; };
__device__ __forceinline__ XcdBarrier xcd_barrier_post(unsigned* bar, volatile LAS unsigned* st) {
    XcdBarrier b; b.bar = bar; b.x = xb_xcc_id(); b.st = st;
    if (threadIdx.x == 0) (void)xb_add(&bar[XB_XCNT(b.x)], 1u);
    return b;
}
__device__ __forceinline__ void xcd_barrier_complete(unsigned* bar, unsigned x, unsigned& nloc, unsigned& nx) {
    const unsigned G = gridDim.x * gridDim.y * gridDim.z;
    unsigned sum, cnt, mine, sp = 0u;
    for (;;) {
        sum = 0u; cnt = 0u; mine = 0u;
#pragma unroll
        for (unsigned j = 0; j < 16; ++j) { const unsigned c = xb_ld(&bar[XB_XCNT(j)]); sum += c; cnt += (c > 0u) ? 1u : 0u; mine = (j == x) ? c : mine; }
        if (sum == G) break;
        __builtin_amdgcn_s_sleep(1);
        if ((++sp & 255u) == 0u) { if (xb_ld(&bar[XB_TMO])) break; if (sp > XB_SPIN_CAP) { atomicAdd(&bar[XB_TMO], 1u); break; } }
    }
    nloc = mine > 0u ? mine : 1u; nx = cnt > 0u ? cnt : 1u;
}
__device__ __forceinline__ void xcd_barrier(const XcdBarrier& b) {
    asm volatile("s_waitcnt vmcnt(0)" ::: "memory");
    __syncthreads();
    if (threadIdx.x == 0) {
        unsigned* bar = b.bar;
        __builtin_amdgcn_s_waitcnt(0);
        unsigned nloc = b.st[0], nx = b.st[1];
        if (nloc == 0u) { xcd_barrier_complete(bar, b.x, nloc, nx); b.st[0] = nloc; b.st[1] = nx; }
        const unsigned old = xb_add(&bar[XB_XSUB(b.x)], 1u);
        const unsigned gen = old / nloc;
        if (old + 1u == (gen + 1u) * nloc) {
            __builtin_amdgcn_fence(__ATOMIC_RELEASE, "agent");
            asm volatile("s_waitcnt vmcnt(0)" ::: "memory");
            const unsigned og = xb_add(&bar[XB_TOP], 1u);
            const unsigned tg = og / nx;
            if (og + 1u == (tg + 1u) * nx) xb_add(&bar[XB_TOPGEN], 1u);
            else XB_SPIN(xb_ld(&bar[XB_TOPGEN]) == tg, bar);
            __builtin_amdgcn_fence(__ATOMIC_ACQUIRE, "agent");
            xb_add(&bar[XB_XGEN(b.x)], 1u);
            asm volatile("s_waitcnt vmcnt(0)" ::: "memory");
        } else {
            XB_SPIN(xb_ld(&bar[XB_XGEN(b.x)]) == gen, bar);
            __builtin_amdgcn_fence(__ATOMIC_ACQUIRE, "agent");
            asm volatile("s_waitcnt vmcnt(0)" ::: "memory");
        }
    }
    __syncthreads();
}

#define GSYNC_CG() do { asm volatile("s_waitcnt vmcnt(0)" ::: "memory"); grid.sync(); } while (0)
#define GSYNC() do { for (int rs_ = 0; rs_ < 1 + PROBE_SYNC; ++rs_) xcd_barrier(xb); } while (0)

#ifndef DBG_STOP
#define DBG_STOP 0
#endif
__device__ __forceinline__ void dbg_dump_bf16(float* out, const bf16_t* src) {
  for (size_t i = (size_t)blockIdx.x * 256 + threadIdx.x; i < (size_t)S_ * D_; i += (size_t)gridDim.x * 256) out[i] = bf2f(src[i]);
}
__global__ void __launch_bounds__(256, 2) fwd_megakernel(Params p) {
  extern __shared__ __attribute__((aligned(16))) char smem[];
  cg::grid_group grid = cg::this_grid();
  char* ws = p.ws;
  bf16_t* XB = (bf16_t*)(ws + OFF_XB);
  bf16_t* H = (bf16_t*)(ws + OFF_H);
  bf16_t* Y = (bf16_t*)(ws + OFF_Y);

  volatile LAS unsigned* xst = (volatile LAS unsigned*)(smem + LDS_BYTES);
  if (threadIdx.x == 0) { xst[0] = 0u; xst[1] = 0u; }
  __syncthreads();
  const XcdBarrier xb = xcd_barrier_post((unsigned*)(ws + OFF_BAR), xst);
  for (int rc_ = 0; rc_ < 1 + PROBE_CONV; ++rc_) phase_convert(p, smem);
  if (p.ws == nullptr) GSYNC_CG();
  GSYNC();
  if (DBG_STOP == 1) { dbg_dump_bf16(p.out, (const bf16_t*)(ws + OFF_WINE)); return; }

  for (int layer = 0; layer < 4; ++layer) {
    const int li = layer >> 1;
    const float* xprev = (layer == 0) ? p.x : p.out;
    if ((layer & 1) == 0) {
      {
        EpiEvenIn epi{H, (float*)(ws + OFF_DT)};
        for (int rep = 0; rep < 1 + PROBE_GEMM; ++rep)
        gemm_phase<false>(XB, D_, (const bf16_t*)(ws + OFF_WINE + (size_t)li * SZ_WINE), D_, S_, EINP, D_, epi, smem);
      }
      GSYNC();
      if (DBG_STOP == 2) { dbg_dump_bf16(p.out, H); return; }
      {
        float d1 = 0.f, d2 = 0.f;
        for (int j = 0; j < 64; ++j) { d1 += p.lq1[li * 64 + j] * p.lk1[li * 64 + j]; d2 += p.lq2[li * 64 + j] * p.lk2[li * 64 + j]; }
        const float lam_init = 0.8f - 0.6f * expf(-0.3f * (float)layer);
        const float lam = expf(d1) - expf(d2) + lam_init;
        const int nitem = 512 + 512;
        for (int rep2 = 0; rep2 < 1 + PROBE_B; ++rep2)
        for (int it = blockIdx.x; it < nitem; it += gridDim.x) {
          if (it < 512) {
            ssd_item(p, li, it >> 2, (it >> 1) & 1, (it & 1) * 4, smem);
          } else {
            const int pr = it - 512, head = pr & 7, c = pr >> 3;
#pragma unroll 1
            for (int rep = 0; rep < 2; ++rep) attn_item1(H, Y, p.subln_g + li * 128, lam, 1.f - lam_init, head, rep ? 127 - c : c, smem);
          }
        }
      }
      GSYNC();
      if (DBG_STOP == 3) {
        for (size_t i = (size_t)blockIdx.x * 256 + threadIdx.x; i < (size_t)S_ * 1024; i += (size_t)gridDim.x * 256) {
          const size_t r = i >> 10, c = i & 1023;
          p.out[r * D_ + c] = (DBG_SUB != 2) ? bf2f(Y[r * D_ + c]) : 0.f; { float yv = ((const float*)(ws + OFF_YS))[i]; if (!(fabsf(yv) < 1e30f)) yv = 12345.f; p.out[r * D_ + 1024 + c] = (DBG_SUB != 1) ? yv : 0.f; }
        }
        return;
      }
      if (DBG_STOP == 6) { for (size_t i = (size_t)blockIdx.x * 256 + threadIdx.x; i < (size_t)S_ * D_; i += (size_t)gridDim.x * 256) p.out[i] = ((const float*)(ws + OFF_ST))[i]; return; }
      phase_scan(p);
      GSYNC();
      for (int it = blockIdx.x; it < 512; it += gridDim.x) ssd_out_item(p, li, it >> 2, (it >> 1) & 1, it & 1, smem);
      GSYNC();
      if (DBG_STOP == 4) { dbg_dump_bf16(p.out, Y); return; }
      {
        EpiOut epi{p.x, layer ? (const float*)(ws + OFF_STATS) : nullptr, p.ln_g + (size_t)(layer ? layer - 1 : 0) * D_, p.ln_b + (size_t)(layer ? layer - 1 : 0) * D_, (bf16_t*)(ws + OFF_T)};
        gemm_phase<false>(Y, D_, (const bf16_t*)(ws + OFF_WOUTE + (size_t)li * SZ_W2K), D_, S_, D_, D_, epi, smem);
      }
    } else {
      {
        EpiOddIn epi{H};
        gemm_phase<false>(XB, D_, (const bf16_t*)(ws + OFF_WINO + (size_t)li * SZ_WINO), D_, S_, 4096, D_, epi, smem);
      }
      GSYNC();
      for (int rp_ = 0; rp_ < 1 + PROBE_CONV; ++rp_) phase_pool(H, (bf16_t*)(ws + OFF_POOL));
      GSYNC();
      {
        EpiGrp epi{H, p.od_b_grp + (size_t)li * 2048, p.od_scale + (size_t)li * 2048, Y};
        gemm_phase<true>((const bf16_t*)(ws + OFF_POOL), D_, (const bf16_t*)(ws + OFF_WGRP + (size_t)li * SZ_WGRP), 512, S_, D_, 512, epi, smem);
      }
      GSYNC();
      {
        EpiOut epi{p.x, layer ? (const float*)(ws + OFF_STATS) : nullptr, p.ln_g + (size_t)(layer ? layer - 1 : 0) * D_, p.ln_b + (size_t)(layer ? layer - 1 : 0) * D_, (bf16_t*)(ws + OFF_T)};
        gemm_phase<false>(Y, D_, (const bf16_t*)(ws + OFF_WOUTO + (size_t)li * SZ_W2K), D_, S_, D_, D_, epi, smem);
      }
    }
    GSYNC();
    phase_ln((const bf16_t*)(ws + OFF_T), p.out, XB, p.ln_g + (size_t)layer * D_, p.ln_b + (size_t)layer * D_, (float*)(ws + OFF_STATS), layer == 3);
    if (DBG_STOP == 5 && layer == 0) return;
    if (DBG_STOP == 7 && layer == 1) return;
    if (layer < 3) GSYNC();
  }
}

extern "C" void kernel_launch(void* const* d_in, const int* in_sizes, int n_in, void* d_out, int out_size, void* d_ws, size_t ws_size,
                              hipStream_t stream) {
  static int grid_blocks = 0;
  if (!grid_blocks) {
    int dev = 0, cus = 0, per_cu = 0;
    hipGetDevice(&dev);
    hipDeviceGetAttribute(&cus, hipDeviceAttributeMultiprocessorCount, dev);
    hipFuncSetAttribute((const void*)fwd_megakernel, hipFuncAttributeMaxDynamicSharedMemorySize, LDS_TOTAL);
    hipOccupancyMaxActiveBlocksPerMultiprocessor(&per_cu, fwd_megakernel, 256, LDS_TOTAL);
    if (per_cu > 2) per_cu = 2;
    if (per_cu < 1) per_cu = 1;
    grid_blocks = cus * per_cu;
  }
  if (ws_size < OFF_END2) { fprintf(stderr, "workspace too small: %zu < %zu\n", ws_size, (size_t)OFF_END); return; }
  Params p{};
  const float** pf = (const float**)&p;
  for (int i = 0; i < 21; ++i) pf[i] = (const float*)d_in[i];
  p.out = (float*)d_out; p.ws = (char*)d_ws;
  hipMemsetAsync((char*)d_ws + OFF_BAR, 0, XCD_BAR_WORDS * 4, stream);
  void* args[] = {&p};
  hipError_t e = hipLaunchCooperativeKernel((void*)fwd_megakernel, dim3(grid_blocks), dim3(256), args, LDS_TOTAL, stream);
  if (e != hipSuccess) fprintf(stderr, "cooperative launch failed: %s (grid %d)\n", hipGetErrorString(e), grid_blocks);
}
```

```cpp
#include <hip/hip_runtime.h>
#include <hip/hip_cooperative_groups.h>
#include <cstdio>
namespace cg = cooperative_groups;
#define DBG_SUB 0
#define PROBE_GEMM 0
#define PROBE_B 0
#define PROBE_SYNC 0
#define PROBE_CONV 0

typedef unsigned short bf16_t;
typedef short bf16x8 __attribute__((ext_vector_type(8)));
typedef short s16x4 __attribute__((ext_vector_type(4)));
typedef float f32x4 __attribute__((ext_vector_type(4)));
typedef unsigned u32x4 __attribute__((ext_vector_type(4)));
typedef unsigned u32x2 __attribute__((ext_vector_type(2)));

constexpr int S_ = 8192, D_ = 2048;
constexpr int EIN = 6672, EINP = 6784, HS = 6656;
constexpr int OHS = 4096;
constexpr int NCHUNK = 128;
constexpr float ALPHA = 1.6817928305074290f;
constexpr float LN_EPS = 1e-5f, RMS_EPS = 1e-5f;
constexpr int LDS_BYTES = 65536, LDS_TOTAL = LDS_BYTES + 16;

constexpr size_t SZ_WINE = (size_t)EINP * 2048 * 2, SZ_W2K = (size_t)2048 * 2048 * 2, SZ_WINO = (size_t)4096 * 2048 * 2, SZ_WGRP = (size_t)4 * 512 * 512 * 2;
constexpr size_t OFF_WINE = 0;
constexpr size_t OFF_WOUTE = OFF_WINE + 2 * SZ_WINE;
constexpr size_t OFF_WINO = OFF_WOUTE + 2 * SZ_W2K;
constexpr size_t OFF_WGRP = OFF_WINO + 2 * SZ_WINO;
constexpr size_t OFF_WOUTO = OFF_WGRP + 2 * SZ_WGRP;
constexpr size_t OFF_XB = OFF_WOUTO + 2 * SZ_W2K;
constexpr size_t OFF_H = OFF_XB + (size_t)S_ * D_ * 2;
constexpr size_t OFF_Y = OFF_H + (size_t)S_ * HS * 2;
constexpr size_t OFF_YS = OFF_Y + (size_t)S_ * D_ * 2;
constexpr size_t OFF_ST = OFF_YS + (size_t)S_ * 1024 * 4;
constexpr size_t OFF_DT = OFF_ST + (size_t)NCHUNK * 16 * 64 * 128 * 4;
constexpr size_t OFF_ACS = OFF_DT + (size_t)S_ * 16 * 4;
constexpr size_t OFF_CC = OFF_ACS + (size_t)S_ * 16 * 4;
constexpr size_t OFF_END = OFF_CC + (size_t)S_ * 256 * 2;
constexpr size_t OFF_BAR = OFF_END;
constexpr size_t OFF_STATS = OFF_BAR + 16384;
constexpr size_t OFF_END2 = OFF_STATS + (size_t)S_ * 2 * 4;
constexpr size_t OFF_POOL = OFF_ST;
constexpr size_t OFF_T = OFF_ST + (size_t)NCHUNK * 16 * 64 * 128 * 2;

struct Params {
  const float* x; const float* ev_w_in; const float* ev_conv_w; const float* ev_conv_b; const float* ev_dt_bias;
  const float* ev_a_log; const float* ev_d_skip; const float* ev_ssm_norm_g; const float* lq1; const float* lk1;
  const float* lq2; const float* lk2; const float* subln_g; const float* ev_w_out; const float* od_w_in;
  const float* od_w_grp; const float* od_b_grp; const float* od_scale; const float* od_w_out; const float* ln_g;
  const float* ln_b; float* out; char* ws;
};

typedef __bf16 bf16x2_t __attribute__((ext_vector_type(2)));
typedef float f32x2_t __attribute__((ext_vector_type(2)));
__device__ __forceinline__ unsigned pk_bf16(float lo, float hi) { f32x2_t v = {lo, hi}; bf16x2_t b = __builtin_convertvector(v, bf16x2_t); return __builtin_bit_cast(unsigned, b); }
__device__ __forceinline__ u32x4 pk8_bf16(f32x4 a, f32x4 b) { u32x4 o; o[0] = pk_bf16(a[0], a[1]); o[1] = pk_bf16(a[2], a[3]); o[2] = pk_bf16(b[0], b[1]); o[3] = pk_bf16(b[2], b[3]); return o; }
__device__ __forceinline__ bf16_t f2bf(float f) { return (bf16_t)(pk_bf16(f, 0.f) & 0xffffu); }
__device__ __forceinline__ float bf2f(unsigned v) { return __uint_as_float(v << 16); }
__device__ __forceinline__ float bflo(unsigned v) { return __uint_as_float(v << 16); }
__device__ __forceinline__ float bfhi(unsigned v) { return __uint_as_float(v & 0xffff0000u); }
typedef _Float16 h16x2_t __attribute__((ext_vector_type(2)));
__device__ __forceinline__ unsigned pk_f16(float lo, float hi) { f32x2_t v = {lo, hi}; h16x2_t h = __builtin_convertvector(v, h16x2_t); return __builtin_bit_cast(unsigned, h); }
__device__ __forceinline__ f32x2_t up_f16(unsigned u) { h16x2_t h = __builtin_bit_cast(h16x2_t, u); return __builtin_convertvector(h, f32x2_t); }
__device__ __forceinline__ float silu_f(float x) { return x / (1.f + __expf(-x)); }
__device__ __forceinline__ float softplus_f(float x) { return fmaxf(x, 0.f) + log1pf(__expf(-fabsf(x))); }
__device__ __forceinline__ f32x4 mfma16(bf16x8 a, bf16x8 b, f32x4 c) { return __builtin_amdgcn_mfma_f32_16x16x32_bf16(a, b, c, 0, 0, 0); }
__device__ __forceinline__ bf16x8 lds_b128(const char* p) { return *(const bf16x8*)p; }
__device__ __forceinline__ unsigned lds_wave_addr(char* smem, int off) { return (unsigned)__builtin_amdgcn_readfirstlane((int)(unsigned)(size_t)(__attribute__((address_space(3))) char*)smem + off); }
#define LDS_PTR(U32) ((__attribute__((address_space(3))) void*)(size_t)(U32))
__device__ __forceinline__ float xmax16(float v) { const unsigned u = __float_as_uint(v); const u32x2 r = __builtin_amdgcn_permlane16_swap(u, u, false, false); return fmaxf(__uint_as_float(r[0]), __uint_as_float(r[1])); }
__device__ __forceinline__ float xmax32(float v) { const unsigned u = __float_as_uint(v); const u32x2 r = __builtin_amdgcn_permlane32_swap(u, u, false, false); return fmaxf(__uint_as_float(r[0]), __uint_as_float(r[1])); }
__device__ __forceinline__ int opaque_tid() { int t = threadIdx.x; asm volatile("" : "+v"(t)); return t; }

__device__ __forceinline__ void transpose_tiles(const float* __restrict__ W, bf16_t* __restrict__ Wt, int K, int N, int Npad, int nmat,
                                                size_t src_stride, size_t dst_stride, char* smem) {
  float* tile = (float*)smem;
  const int tid = opaque_tid();
  const int tk = K / 64, tn = Npad / 64, per = tk * tn, total = per * nmat;
  for (int t = blockIdx.x; t < total; t += gridDim.x) {
    const int mat = t / per, r = t % per, kt = r / tn, nt = r % tn;
    const float* src = W + (size_t)mat * src_stride;
    bf16_t* dst = Wt + (size_t)mat * dst_stride;
    const int k0 = kt * 64, n0 = nt * 64;
    __syncthreads();
#pragma unroll
    for (int i = 0; i < 4; ++i) {
      const int rr = (tid >> 4) + 16 * i, c4 = (tid & 15) * 4;
      f32x4 v = {0.f, 0.f, 0.f, 0.f};
      if (n0 + c4 < N) v = *(const f32x4*)(src + (size_t)(k0 + rr) * N + n0 + c4);
      tile[rr * 65 + c4 + 0] = v[0]; tile[rr * 65 + c4 + 1] = v[1]; tile[rr * 65 + c4 + 2] = v[2]; tile[rr * 65 + c4 + 3] = v[3];
    }
    __syncthreads();
#pragma unroll
    for (int j = 0; j < 2; ++j) {
      const int n = (tid >> 3) + 32 * j, kc = (tid & 7) * 8;
      u32x4 o;
      o[0] = pk_bf16(tile[(kc + 0) * 65 + n], tile[(kc + 1) * 65 + n]);
      o[1] = pk_bf16(tile[(kc + 2) * 65 + n], tile[(kc + 3) * 65 + n]);
      o[2] = pk_bf16(tile[(kc + 4) * 65 + n], tile[(kc + 5) * 65 + n]);
      o[3] = pk_bf16(tile[(kc + 6) * 65 + n], tile[(kc + 7) * 65 + n]);
      *(u32x4*)(dst + (size_t)(n0 + n) * K + k0 + kc) = o;
    }
  }
}

__device__ __forceinline__ void phase_convert(const Params& p, char* smem) {
  char* ws = p.ws;
  transpose_tiles(p.ev_w_in, (bf16_t*)(ws + OFF_WINE), 2048, EIN, EINP, 2, (size_t)2048 * EIN, (size_t)EINP * 2048, smem);
  transpose_tiles(p.ev_w_out, (bf16_t*)(ws + OFF_WOUTE), 2048, 2048, 2048, 2, (size_t)2048 * 2048, (size_t)2048 * 2048, smem);
  transpose_tiles(p.od_w_in, (bf16_t*)(ws + OFF_WINO), 2048, 4096, 4096, 2, (size_t)2048 * 4096, (size_t)4096 * 2048, smem);
  transpose_tiles(p.od_w_grp, (bf16_t*)(ws + OFF_WGRP), 512, 512, 512, 8, (size_t)512 * 512, (size_t)512 * 512, smem);
  transpose_tiles(p.od_w_out, (bf16_t*)(ws + OFF_WOUTO), 2048, 2048, 2048, 2, (size_t)2048 * 2048, (size_t)2048 * 2048, smem);
  bf16_t* xb = (bf16_t*)(ws + OFF_XB);
  const size_t n4 = (size_t)S_ * D_ / 4;
  for (size_t i = (size_t)blockIdx.x * 256 + opaque_tid(); i < n4; i += (size_t)gridDim.x * 256) {
    f32x4 v = *(const f32x4*)(p.x + i * 4);
    u32x2 o; o[0] = pk_bf16(v[0], v[1]); o[1] = pk_bf16(v[2], v[3]);
    *(u32x2*)(xb + i * 4) = o;
  }
}

template <bool GROUPED, class Epi>
__device__ __forceinline__ void gemm_phase(const bf16_t* __restrict__ A, int lda, const bf16_t* __restrict__ Bt, int ldb,
                                           int M, int N, int K, const Epi& epi, char* smem) {
  const int tid = opaque_tid(), lane = tid & 63, wave = tid >> 6, wr = wave >> 1, wc = wave & 1, fr = lane & 15, fq = lane >> 4;
  const int nM = M / 128, nN = N / 128, ntile = nM * nN, nkt = K / 64;
  const int G = gridDim.x;
  int vb = blockIdx.x;
  if ((G & 7) == 0) vb = (blockIdx.x & 7) * (G >> 3) + (blockIdx.x >> 3);
  const int lrow = tid >> 3, lch = tid & 7;
  const int prow = 8 * ((lrow & 15) >> 2) + 4 * (lrow >> 4) + (lrow & 3);
  const int st_off = lrow * 128 + ((lch ^ (lrow & 7)) << 4);
  const int swz = fr & 7;
  const int a_off = (wr * 64 + fr) * 128, b_off = 16384 + (wc * 64 + fr) * 128;
  const int c0 = ((fq ^ swz) << 4), c1 = (((4 | fq) ^ swz) << 4);
#define G_DMA(AG, BG, KT, BUF) _Pragma("unroll") for (int i = 0; i < 4; ++i) { \
      __builtin_amdgcn_global_load_lds((const __attribute__((address_space(1))) void*)((AG) + (size_t)(32 * i) * lda + (KT) * 64), LDS_PTR(ldsw + (BUF) * 32768 + i * 4096), 16, 0, 0); \
      __builtin_amdgcn_global_load_lds((const __attribute__((address_space(1))) void*)((BG) + (size_t)(32 * i) * ldb + (KT) * 64), LDS_PTR(ldsw + (BUF) * 32768 + 16384 + i * 4096), 16, 0, 0); }
    \
    \
#define G_COMPUTE(BUF) { const char* buf = smem + (BUF) * 32768; bf16x8 af[4], bfr[4], ag[4], bg[4]; __builtin_amdgcn_s_setprio(1); \
      _Pragma("unroll") for (int j = 0; j < 4; ++j) { bfr[j] = lds_b128(buf + b_off + j * 2048 + c0); af[j] = lds_b128(buf + a_off + j * 2048 + c0); __builtin_amdgcn_sched_barrier(0); } \
      _Pragma("unroll") for (int q = 0; q < 4; ++q) { \
        _Pragma("unroll") for (int m = 0; m < q; ++m) acc[m][q] = mfma16(bfr[q], af[m], acc[m][q]); \
        _Pragma("unroll") for (int n = 0; n <= q; ++n) acc[q][n] = mfma16(bfr[n], af[q], acc[q][n]); \
        bg[q] = lds_b128(buf + b_off + q * 2048 + c1); ag[q] = lds_b128(buf + a_off + q * 2048 + c1); \
        __builtin_amdgcn_sched_barrier(0); } \
      _Pragma("unroll") for (int q = 0; q < 4; ++q) { \
        _Pragma("unroll") for (int m = 0; m < q; ++m) acc[m][q] = mfma16(bg[q], ag[m], acc[m][q]); \
        _Pragma("unroll") for (int n = 0; n <= q; ++n) acc[q][n] = mfma16(bg[n], ag[q], acc[q][n]); } __builtin_amdgcn_s_setprio(0); }
#define G_TILE(T, PM, PN, AG, BG) { const int gid_ = (T) / (8 * nN), within_ = (T) % (8 * nN); PM = gid_ * 8 + (within_ & 7); PN = within_ >> 3; \
      AG = A + (size_t)(PM * 128 + lrow) * lda + ((lch ^ (lrow & 7)) * 8) + (GROUPED ? (PN >> 2) * 512 : 0); \
      BG = Bt + (size_t)(PN * 128 + prow) * ldb + ((lch ^ (lrow & 7)) * 8); }
  const unsigned ldsw = lds_wave_addr(smem, wave * 1024);
  int tile = vb, pm = 0, pn = 0;
  const bf16_t* Ag = A; const bf16_t* Bg = Bt;
  if (tile < ntile) {
    G_TILE(tile, pm, pn, Ag, Bg);
    __syncthreads();
    G_DMA(Ag, Bg, 0, 0);
  }
  while (tile < ntile) {
    f32x4 acc[4][4];
#pragma unroll
    for (int m = 0; m < 4; ++m)
#pragma unroll
      for (int n = 0; n < 4; ++n) acc[m][n] = (f32x4){0.f, 0.f, 0.f, 0.f};
    asm volatile("s_waitcnt vmcnt(0)" ::: "memory");
    __syncthreads();
    for (int kt = 0; kt < nkt; kt += 2) {
      G_DMA(Ag, Bg, kt + 1, 1);
      G_COMPUTE(0);
      asm volatile("s_waitcnt vmcnt(0)" ::: "memory");
      __syncthreads();
      if (kt + 2 < nkt) { G_DMA(Ag, Bg, kt + 2, 0); }
      G_COMPUTE(1);
      asm volatile("s_waitcnt vmcnt(0)" ::: "memory");
      __syncthreads();
    }
    const int tile_n = tile + G, pm_c = pm, pn_c = pn;
    if (tile_n < ntile) { G_TILE(tile_n, pm, pn, Ag, Bg); G_DMA(Ag, Bg, 0, 0); }
#pragma unroll
    for (int m = 0; m < 4; ++m)
#pragma unroll
      for (int gq = 0; gq < 2; ++gq) epi(pm_c * 128 + wr * 64 + m * 16 + fr, pn_c * 128 + wc * 64 + gq * 32 + fq * 8, acc[m][2 * gq], acc[m][2 * gq + 1]);
    tile = tile_n;
  }
#undef G_DMA
#undef G_COMPUTE
#undef G_TILE
}


struct EpiEvenIn {
  bf16_t* H; float* DT;
  __device__ __forceinline__ void operator()(int row, int col, f32x4 lo, f32x4 hi) const {
    if (col < HS) { *(u32x4*)(H + (size_t)row * HS + col) = pk8_bf16(lo, hi); }
    else if (col < EIN) { *(f32x4*)(DT + (size_t)row * 16 + (col - HS)) = lo; *(f32x4*)(DT + (size_t)row * 16 + (col - HS) + 4) = hi; }
  }
};
struct EpiOddIn {
  bf16_t* H;
  __device__ __forceinline__ void operator()(int row, int col, f32x4 lo, f32x4 hi) const { *(u32x4*)(H + (size_t)row * OHS + col) = pk8_bf16(lo, hi); }
};
struct EpiGrp {
  const bf16_t* H; const float* b; const float* sc; bf16_t* Y;
  __device__ __forceinline__ void operator()(int row, int col, f32x4 lo, f32x4 hi) const {
    const u32x4 g = *(const u32x4*)(H + (size_t)row * OHS + 2048 + col);
    f32x4 v[2] = {lo, hi};
#pragma unroll
    for (int q = 0; q < 2; ++q) {
      const f32x4 bb = *(const f32x4*)(b + col + 4 * q), ss = *(const f32x4*)(sc + col + 4 * q);
      v[q][0] = (v[q][0] + bb[0]) * ss[0] * silu_f(bflo(g[2 * q])); v[q][1] = (v[q][1] + bb[1]) * ss[1] * silu_f(bfhi(g[2 * q]));
      v[q][2] = (v[q][2] + bb[2]) * ss[2] * silu_f(bflo(g[2 * q + 1])); v[q][3] = (v[q][3] + bb[3]) * ss[3] * silu_f(bfhi(g[2 * q + 1]));
    }
    *(u32x4*)(Y + (size_t)row * D_ + col) = pk8_bf16(v[0], v[1]);
  }
};
struct EpiOut {
  const float* x0; const float* stats; const float* g; const float* b; bf16_t* T;
  __device__ __forceinline__ void operator()(int row, int col, f32x4 lo, f32x4 hi) const {
    f32x4 xp[2];
    if (stats) {
      const u32x4 t = *(const u32x4*)(T + (size_t)row * D_ + col);
      const float mu = stats[row * 2], rs = stats[row * 2 + 1];
#pragma unroll
      for (int q = 0; q < 2; ++q) {
        const f32x2_t t0 = up_f16(t[2 * q]), t1 = up_f16(t[2 * q + 1]);
        xp[q] = (f32x4){t0[0], t0[1], t1[0], t1[1]};
        xp[q] = (xp[q] - mu) * rs * *(const f32x4*)(g + col + 4 * q) + *(const f32x4*)(b + col + 4 * q);
      }
    } else {
      xp[0] = *(const f32x4*)(x0 + (size_t)row * D_ + col); xp[1] = *(const f32x4*)(x0 + (size_t)row * D_ + col + 4);
    }
    const f32x4 o0 = xp[0] * ALPHA + lo, o1 = xp[1] * ALPHA + hi;
    u32x4 ob; ob[0] = pk_f16(o0[0], o0[1]); ob[1] = pk_f16(o0[2], o0[3]); ob[2] = pk_f16(o1[0], o1[1]); ob[3] = pk_f16(o1[2], o1[3]);
    *(u32x4*)(T + (size_t)row * D_ + col) = ob;
  }
};

__device__ __forceinline__ void phase_ln(const bf16_t* T, float* X, bf16_t* XB, const float* __restrict__ g, const float* __restrict__ b, float* stats, bool write_x) {
  const int tidx = opaque_tid(); const int lane = tidx & 63, gw = blockIdx.x * 4 + (tidx >> 6), nw = gridDim.x * 4;
  for (int row0 = gw; row0 < S_; row0 += 2 * nw) {
    u32x4 raw[2][4];
#pragma unroll
    for (int rr = 0; rr < 2; ++rr) {
      const int row = row0 + rr * nw;
#pragma unroll
      for (int j = 0; j < 4; ++j) { raw[rr][j] = (u32x4){0u, 0u, 0u, 0u}; if (row < S_) raw[rr][j] = *(const u32x4*)(T + (size_t)row * D_ + j * 512 + lane * 8); }
    }
#pragma unroll
    for (int rr = 0; rr < 2; ++rr) {
      const int row = row0 + rr * nw;
      if (row < S_) {
        f32x4 v[8];
        float s = 0.f;
#pragma unroll
        for (int j = 0; j < 4; ++j) {
          const u32x4 t = raw[rr][j];
          const f32x2_t t0 = up_f16(t[0]), t1 = up_f16(t[1]), t2 = up_f16(t[2]), t3 = up_f16(t[3]);
          v[2 * j] = (f32x4){t0[0], t0[1], t1[0], t1[1]}; v[2 * j + 1] = (f32x4){t2[0], t2[1], t3[0], t3[1]};
          s += (v[2 * j][0] + v[2 * j][1] + v[2 * j][2] + v[2 * j][3]) + (v[2 * j + 1][0] + v[2 * j + 1][1] + v[2 * j + 1][2] + v[2 * j + 1][3]);
        }
#pragma unroll
        for (int o = 32; o >= 1; o >>= 1) s += __shfl_xor(s, o);
        const float mu = s * (1.f / D_);
        float q = 0.f;
#pragma unroll
        for (int j = 0; j < 8; ++j) { f32x4 d = v[j] - mu; q += d[0] * d[0] + d[1] * d[1] + d[2] * d[2] + d[3] * d[3]; }
#pragma unroll
        for (int o = 32; o >= 1; o >>= 1) q += __shfl_xor(q, o);
        const float rs = rsqrtf(q * (1.f / D_) + LN_EPS);
        if (lane == 0) { stats[row * 2] = mu; stats[row * 2 + 1] = rs; }
#pragma unroll
        for (int j = 0; j < 4; ++j) {
          const int c = j * 512 + lane * 8;
          const f32x4 o0 = (v[2 * j] - mu) * rs * *(const f32x4*)(g + c) + *(const f32x4*)(b + c);
          const f32x4 o1 = (v[2 * j + 1] - mu) * rs * *(const f32x4*)(g + c + 4) + *(const f32x4*)(b + c + 4);
          if (write_x) { *(f32x4*)(X + (size_t)row * D_ + c) = o0; *(f32x4*)(X + (size_t)row * D_ + c + 4) = o1; }
          *(u32x4*)(XB + (size_t)row * D_ + c) = pk8_bf16(o0, o1);
        }
      }
    }
  }
}

__device__ __forceinline__ void phase_pool(const bf16_t* __restrict__ H, bf16_t* __restrict__ P) {
  const int nitem = 256 * 512;
  for (int it = blockIdx.x * 256 + opaque_tid(); it < nitem; it += gridDim.x * 256) {
    const int c8 = it & 255, seg = it >> 8, w = 2 << (c8 >> 6), t0 = seg * 16;
    const bf16_t* col = H + c8 * 8;
    u32x4 r[31];
#pragma unroll
    for (int i = 0; i < 31; ++i) {
      const int t = t0 - 15 + i;
      r[i] = (u32x4){0u, 0u, 0u, 0u};
      if (t >= 0 && i >= 16 - w) r[i] = *(const u32x4*)(col + (size_t)t * OHS);
    }
    float sum[8];
#pragma unroll
    for (int j = 0; j < 8; ++j) sum[j] = 0.f;
#pragma unroll
    for (int i = 0; i < 15; ++i)
#pragma unroll
      for (int j = 0; j < 4; ++j) { sum[2 * j] += bflo(r[i][j]); sum[2 * j + 1] += bfhi(r[i][j]); }
#pragma unroll
    for (int q = 0; q < 16; ++q) {
      const int t = t0 + q;
      const u32x4 v = r[15 + q];
      float cur[8];
#pragma unroll
      for (int j = 0; j < 4; ++j) { cur[2 * j] = bflo(v[j]); cur[2 * j + 1] = bfhi(v[j]); }
#pragma unroll
      for (int j = 0; j < 8; ++j) sum[j] += cur[j];
      const float inv = 1.f / (float)min(t + 1, w);
      u32x4 o;
#pragma unroll
      for (int j = 0; j < 4; ++j) o[j] = pk_bf16(sum[2 * j] * inv - cur[2 * j], sum[2 * j + 1] * inv - cur[2 * j + 1]);
      *(u32x4*)(P + (size_t)t * D_ + c8 * 8) = o;
      const u32x4 u = (w == 16) ? r[q] : (w == 8) ? r[q + 8] : (w == 4) ? r[q + 12] : r[q + 14];
#pragma unroll
      for (int j = 0; j < 4; ++j) { sum[2 * j] -= bflo(u[j]); sum[2 * j + 1] -= bfhi(u[j]); }
    }
  }
}

__device__ __forceinline__ void attn_item1(const bf16_t* __restrict__ H, bf16_t* __restrict__ Y, const float* __restrict__ subln, float lam, float outscale,
                                           int head, int chunk, char* smem) {
  const int tid = opaque_tid(), lane = tid & 63, wave = tid >> 6, fr = lane & 15, fq = lane >> 4;
  const float cs = 0.125f * 1.4426950408889634f;
  const int ntiles = chunk + 1;
  const size_t qrow = (size_t)chunk * 64 + wave * 16 + fr;
  bf16x8 Qf[2][2];
#pragma unroll
  for (int hf = 0; hf < 2; ++hf)
#pragma unroll
    for (int ks = 0; ks < 2; ++ks) Qf[hf][ks] = *(const bf16x8*)(H + qrow * HS + head * 128 + hf * 64 + ks * 32 + fq * 8);
  const bf16_t* Kg = H + 1024 + head * 128;
  const bf16_t* Vg = H + 2048 + head * 128;
  const int pfr = (fr & 3) | ((fr & 4) << 1) | ((fr & 8) >> 1);
  int koff[4];
#pragma unroll
  for (int a = 0; a < 4; ++a) koff[a] = pfr * 256 + (((a * 4) ^ (pfr & 12)) << 4) + ((fq ^ (pfr & 3)) << 4);
  const int ld_row = tid >> 4, ld_ch = tid & 15;
  const unsigned kld_off = (unsigned)((ld_row * HS + ((ld_ch ^ ld_row) * 8)) * 2);
  const unsigned vld_off = (unsigned)((ld_row * HS + ((ld_ch ^ (((ld_row & 3) << 2) | ((ld_row >> 2) & 3))) * 8)) * 2);
#define A1_DMA(GBASE, OFF, LDSBASE) _Pragma("unroll") for (int i = 0; i < 4; ++i) \
    __builtin_amdgcn_global_load_lds((const __attribute__((address_space(1))) void*)((GBASE) + (size_t)i * (16 * HS * 2) + (OFF)), LDS_PTR(ldsw + (LDSBASE) + i * 4096), 16, 0, 0)
  const unsigned ldsw = lds_wave_addr(smem, wave * 1024);
  const int gl = lane & 15, tq = gl >> 2, tp = gl & 3;
  const int pq = ((fq & 1) << 1) | (fq >> 1);
  const int v_row = pq * 4 + tq;
  const int v_x = (tq << 2) | pq, v_hi = tp >> 1, v_lo = (tp & 1) * 8;
  float mx[2] = {-INFINITY, -INFINITY}, ls[2] = {0.f, 0.f};
  f32x4 O[2][8];
#pragma unroll
  for (int hf = 0; hf < 2; ++hf)
#pragma unroll
    for (int eb = 0; eb < 8; ++eb) O[hf][eb] = (f32x4){0.f, 0.f, 0.f, 0.f};
  __syncthreads();
  A1_DMA((const char*)Kg, kld_off, 0);
  A1_DMA((const char*)Vg, vld_off, 32768);
  for (int t = 0; t < ntiles; ++t) {
    asm volatile("s_waitcnt vmcnt(0)" ::: "memory");
    __builtin_amdgcn_s_barrier();
    asm volatile("" ::: "memory");
    if (t + 1 < ntiles) {
      A1_DMA((const char*)(Kg + (size_t)((t + 1) * 64) * HS), kld_off, ((t + 1) & 1) * 16384);
      A1_DMA((const char*)(Vg + (size_t)((t + 1) * 64) * HS), vld_off, 32768 + ((t + 1) & 1) * 16384);
    }
    const char* Kb = smem + (t & 1) * 16384;
    const char* Vb = smem + 32768 + (t & 1) * 16384;
    bf16x8 Pf[2][2];
    bf16x8 kf[2][4][2];
#pragma unroll
    for (int hf = 0; hf < 2; ++hf)
#pragma unroll
      for (int kb = 0; kb < 4; ++kb)
#pragma unroll
        for (int ks = 0; ks < 2; ++ks) kf[hf][kb][ks] = lds_b128(Kb + koff[hf * 2 + ks] + kb * 4096);
    __builtin_amdgcn_sched_group_barrier(0x100, 16, 0);
    f32x4 Sx[2][4];
    float mn[2];
#pragma unroll
    for (int hf = 0; hf < 2; ++hf) {
#pragma unroll
      for (int kb = 0; kb < 4; ++kb) Sx[hf][kb] = (f32x4){0.f, 0.f, 0.f, 0.f};
#pragma unroll
      for (int kb = 0; kb < 4; ++kb)
#pragma unroll
        for (int ks = 0; ks < 2; ++ks) Sx[hf][kb] = mfma16(kf[hf][kb][ks], Qf[hf][ks], Sx[hf][kb]);
    }
#pragma unroll
    for (int hf = 0; hf < 2; ++hf) {
      float tm = -INFINITY;
#pragma unroll
      for (int kb = 0; kb < 4; ++kb)
#pragma unroll
        for (int r = 0; r < 4; ++r) tm = fmaxf(tm, Sx[hf][kb][r]);
      tm = xmax16(tm); tm = xmax32(tm);
      mn[hf] = fmaxf(mx[hf], tm * cs);
    }
    if (__builtin_amdgcn_ballot_w64((mn[0] > mx[0] + 8.0f) || (mn[1] > mx[1] + 8.0f)) != 0ull) {
#pragma unroll
      for (int hf = 0; hf < 2; ++hf) {
        const float alpha = __builtin_amdgcn_exp2f(mx[hf] - mn[hf]);
        ls[hf] *= alpha;
#pragma unroll
        for (int eb = 0; eb < 8; ++eb) O[hf][eb] *= alpha;
        mx[hf] = mn[hf];
      }
    }
#pragma unroll
    for (int hf = 0; hf < 2; ++hf) {
      float pv[16], sum = 0.f;
#pragma unroll
      for (int kb = 0; kb < 4; ++kb)
#pragma unroll
        for (int r = 0; r < 4; ++r) { pv[kb * 4 + r] = __builtin_amdgcn_exp2f(Sx[hf][kb][r] * cs - mx[hf]); sum += pv[kb * 4 + r]; }
      ls[hf] += sum;
#pragma unroll
      for (int ks2 = 0; ks2 < 2; ++ks2) {
        u32x4 pk;
        pk[0] = pk_bf16(pv[(2 * ks2) * 4 + 0], pv[(2 * ks2) * 4 + 1]); pk[1] = pk_bf16(pv[(2 * ks2) * 4 + 2], pv[(2 * ks2) * 4 + 3]);
        pk[2] = pk_bf16(pv[(2 * ks2 + 1) * 4 + 0], pv[(2 * ks2 + 1) * 4 + 1]); pk[3] = pk_bf16(pv[(2 * ks2 + 1) * 4 + 2], pv[(2 * ks2 + 1) * 4 + 3]);
        Pf[hf][ks2] = __builtin_bit_cast(bf16x8, pk);
      }
    }
#pragma unroll
    for (int eh = 0; eh < 2; ++eh) {
      s16x4 va[4][2], vb[4][2];
#pragma unroll
      for (int e4 = 0; e4 < 4; ++e4)
#pragma unroll
        for (int ks2 = 0; ks2 < 2; ++ks2) {
          const int eb = eh * 4 + e4;
          const int cho = (((2 * eb + v_hi) ^ v_x) << 4) + v_lo;
          const int ra = v_row + (2 * ks2) * 16, rb = ra + 16;
          va[e4][ks2] = __builtin_amdgcn_ds_read_tr16_b64_v4i16((__attribute__((address_space(3))) s16x4*)(Vb + ra * 256 + cho));
          vb[e4][ks2] = __builtin_amdgcn_ds_read_tr16_b64_v4i16((__attribute__((address_space(3))) s16x4*)(Vb + rb * 256 + cho));
        }
#pragma unroll
      for (int e4 = 0; e4 < 4; ++e4)
#pragma unroll
        for (int ks2 = 0; ks2 < 2; ++ks2) {
          const int eb = eh * 4 + e4;
          bf16x8 vf; vf[0] = va[e4][ks2][0]; vf[1] = va[e4][ks2][1]; vf[2] = va[e4][ks2][2]; vf[3] = va[e4][ks2][3];
          vf[4] = vb[e4][ks2][0]; vf[5] = vb[e4][ks2][1]; vf[6] = vb[e4][ks2][2]; vf[7] = vb[e4][ks2][3];
          O[0][eb] = mfma16(vf, Pf[0][ks2], O[0][eb]);
          O[1][eb] = mfma16(vf, Pf[1][ks2], O[1][eb]);
        }
    }
    __builtin_amdgcn_sched_group_barrier(0x100, 16, 0);
#pragma unroll
    for (int g = 0; g < 4; ++g) { __builtin_amdgcn_sched_group_barrier(0x008, 4, 0); __builtin_amdgcn_sched_group_barrier(0x100, 4, 0); }
    __builtin_amdgcn_sched_group_barrier(0x008, 16, 0);
  }
#undef A1_DMA
  float l0 = ls[0], l1 = ls[1];
  l0 += __shfl_xor(l0, 16); l0 += __shfl_xor(l0, 32);
  l1 += __shfl_xor(l1, 16); l1 += __shfl_xor(l1, 32);
  const float i0 = 1.f / l0, i1 = lam / l1;
  float ss = 0.f;
#pragma unroll
  for (int eb = 0; eb < 8; ++eb) {
    O[0][eb] = O[0][eb] * i0 - O[1][eb] * i1;
    ss += O[0][eb][0] * O[0][eb][0] + O[0][eb][1] * O[0][eb][1] + O[0][eb][2] * O[0][eb][2] + O[0][eb][3] * O[0][eb][3];
  }
  ss += __shfl_xor(ss, 16); ss += __shfl_xor(ss, 32);
  const float rs = rsqrtf(ss * (1.f / 128.f) + RMS_EPS) * outscale;
#pragma unroll
  for (int eb = 0; eb < 8; ++eb) {
    const int e = eb * 16 + fq * 4;
    const f32x4 sg = *(const f32x4*)(subln + e);
    const u32x2 g = *(const u32x2*)(H + qrow * HS + 3072 + head * 128 + e);
    const float r0 = O[0][eb][0] * rs * sg[0] * silu_f(bflo(g[0])), r1 = O[0][eb][1] * rs * sg[1] * silu_f(bfhi(g[0]));
    const float r2 = O[0][eb][2] * rs * sg[2] * silu_f(bflo(g[1])), r3 = O[0][eb][3] * rs * sg[3] * silu_f(bfhi(g[1]));
    u32x2 o; o[0] = pk_bf16(r0, r1); o[1] = pk_bf16(r2, r3);
    *(u32x2*)(Y + qrow * D_ + head * 128 + e) = o;
  }
}

__device__ __forceinline__ f32x4 mma_lds(const bf16_t* X, int ldx, const bf16_t* Yp, int ldy, int K, int fr, int fq) {
  f32x4 acc = {0.f, 0.f, 0.f, 0.f};
  for (int k0 = 0; k0 < K; k0 += 32) {
    const bf16x8 a = *(const bf16x8*)(X + fr * ldx + k0 + fq * 8);
    const bf16x8 b = *(const bf16x8*)(Yp + fr * ldy + k0 + fq * 8);
    acc = mfma16(a, b, acc);
  }
  return acc;
}

constexpr int SSD_ACS = 0, SSD_DT = 2048, SSD_BT = 4096, SSD_G = SSD_BT + 128 * 72 * 2, SSD_R = SSD_G + 64 * 72 * 2;
constexpr int SSD_CS = SSD_R, SSD_BS = SSD_R + 64 * 128 * 2;
constexpr int SSD_XDT = SSD_R, SSD_XDEC = SSD_R + 9216, SSD_M = SSD_R + 18432;
static_assert(SSD_R + 27648 <= LDS_BYTES, "lds");
static_assert(SSD_BS + 64 * 128 * 2 <= LDS_BYTES, "lds");

__device__ __forceinline__ void ssd_item(const Params& p, int li, int chunk, int grp, int hbeg, char* smem) {
  const int tid = opaque_tid(), lane = tid & 63, wave = tid >> 6, fr = lane & 15, fq = lane >> 4;
  char* ws = p.ws;
  const bf16_t* H = (const bf16_t*)(ws + OFF_H);
  const float* DT = (const float*)(ws + OFF_DT);
  float* ACS = (float*)(ws + OFF_ACS);
  bf16_t* CC = (bf16_t*)(ws + OFF_CC);
  bf16_t* YS = (bf16_t*)(ws + OFF_YS);
  bf16_t* ST = (bf16_t*)(ws + OFF_ST);
  const float* conv_w = p.ev_conv_w + (size_t)li * 4 * 1536;
  const float* conv_b = p.ev_conv_b + (size_t)li * 1536;
  float* acs_s = (float*)(smem + SSD_ACS); float* dt_s = (float*)(smem + SSD_DT);
  bf16_t* BT = (bf16_t*)(smem + SSD_BT); bf16_t* Gs = (bf16_t*)(smem + SSD_G);
  bf16_t* Cs = (bf16_t*)(smem + SSD_CS); bf16_t* Bs = (bf16_t*)(smem + SSD_BS);
  bf16_t* xdtT = (bf16_t*)(smem + SSD_XDT); bf16_t* xdecT = (bf16_t*)(smem + SSD_XDEC); bf16_t* Ms = (bf16_t*)(smem + SSD_M);
  const int tok0 = chunk * 64;
  __syncthreads();
  {
    const int hh = hbeg + wave, h = grp * 8 + hh;
    const float dtv = softplus_f(DT[(size_t)(tok0 + lane) * 16 + h] + p.ev_dt_bias[li * 16 + h]);
    float a = -__expf(p.ev_a_log[li * 16 + h]) * dtv;
#pragma unroll
    for (int o = 1; o < 64; o <<= 1) { const float t = __shfl_up(a, o); if (lane >= o) a += t; }
    dt_s[hh * 64 + lane] = dtv; acs_s[hh * 64 + lane] = a;
    ACS[(size_t)(tok0 + lane) * 16 + h] = a;
  }
  {
    const int cp = tid & 127, lseg = tid >> 7, j0 = cp * 2;
    const int isC = j0 >= 128, n0 = j0 & 127;
    const int xch = 1024 + (isC ? 256 : 0) + grp * 128 + n0;
    const bf16_t* src = H + 5120 + xch;
    float w0[4], w1[4];
#pragma unroll
    for (int j = 0; j < 4; ++j) { w0[j] = conv_w[j * 1536 + xch]; w1[j] = conv_w[j * 1536 + xch + 1]; }
    const float b0 = conv_b[xch], b1 = conv_b[xch + 1];
    float h0[3], h1[3];
#pragma unroll
    for (int j = 0; j < 3; ++j) {
      const int t = tok0 + lseg * 32 - 3 + j;
      unsigned v = 0; if (t >= 0) v = *(const unsigned*)(src + (size_t)t * HS);
      h0[j] = bflo(v); h1[j] = bfhi(v);
    }
    for (int l = lseg * 32; l < lseg * 32 + 32; ++l) {
      const unsigned v = *(const unsigned*)(src + (size_t)(tok0 + l) * HS);
      const float c0 = bflo(v), c1 = bfhi(v);
      const float y0 = silu_f(b0 + w0[0] * h0[0] + w0[1] * h0[1] + w0[2] * h0[2] + w0[3] * c0);
      const float y1 = silu_f(b1 + w1[0] * h1[0] + w1[1] * h1[1] + w1[2] * h1[2] + w1[3] * c1);
      h0[0] = h0[1]; h0[1] = h0[2]; h0[2] = c0; h1[0] = h1[1]; h1[1] = h1[2]; h1[2] = c1;
      const unsigned pk = pk_bf16(y0, y1);
      if (isC) { *(unsigned*)(Cs + l * 128 + n0) = pk; *(unsigned*)(CC + (size_t)(tok0 + l) * 256 + grp * 128 + n0) = pk; }
      else { *(unsigned*)(Bs + l * 128 + n0) = pk; BT[n0 * 72 + l] = (bf16_t)(pk & 0xffffu); BT[(n0 + 1) * 72 + l] = (bf16_t)(pk >> 16); }
    }
  }
  __syncthreads();
#pragma unroll
  for (int sb = 0; sb < 4; ++sb) {
    const f32x4 g = mma_lds(Cs + wave * 16 * 128, 128, Bs + sb * 16 * 128, 128, 128, fr, fq);
#pragma unroll
    for (int r = 0; r < 4; ++r) Gs[(wave * 16 + fq * 4 + r) * 72 + sb * 16 + fr] = f2bf(g[r]);
#if DBG_SUB == 3
    for (int r = 0; r < 4; ++r) YS[(size_t)(tok0 + wave * 16 + fq * 4 + r) * 1024 + grp * 512 + sb * 16 + fr] = g[r];
#endif
  }
  __syncthreads();
  for (int hh = hbeg; hh < hbeg + 4; ++hh) {
    const int h = grp * 8 + hh;
    const float* acs = acs_s + hh * 64; const float* dts = dt_s + hh * 64;
    const float acs_last = acs[63];
    {
      const int pp = tid & 31, lseg = tid >> 5, p0 = pp * 2;
      const int xch = grp * 512 + hh * 64 + p0;
      const bf16_t* src = H + 5120 + xch;
      float w0[4], w1[4];
#pragma unroll
      for (int j = 0; j < 4; ++j) { w0[j] = conv_w[j * 1536 + xch]; w1[j] = conv_w[j * 1536 + xch + 1]; }
      const float b0 = conv_b[xch], b1 = conv_b[xch + 1];
      float h0[3], h1[3];
#pragma unroll
      for (int j = 0; j < 3; ++j) {
        const int t = tok0 + lseg * 8 - 3 + j;
        unsigned v = 0; if (t >= 0) v = *(const unsigned*)(src + (size_t)t * HS);
        h0[j] = bflo(v); h1[j] = bfhi(v);
      }
#pragma unroll
      for (int q = 0; q < 8; ++q) {
        const int l = lseg * 8 + q;
        const unsigned v = *(const unsigned*)(src + (size_t)(tok0 + l) * HS);
        const float c0 = bflo(v), c1 = bfhi(v);
        const float y0 = silu_f(b0 + w0[0] * h0[0] + w0[1] * h0[1] + w0[2] * h0[2] + w0[3] * c0);
        const float y1 = silu_f(b1 + w1[0] * h1[0] + w1[1] * h1[1] + w1[2] * h1[2] + w1[3] * c1);
        h0[0] = h0[1]; h0[1] = h0[2]; h0[2] = c0; h1[0] = h1[1]; h1[1] = h1[2]; h1[2] = c1;
        const float dtl = dts[l], dec = __expf(acs_last - acs[l]);
        const unsigned a = pk_bf16(y0 * dtl, y1 * dtl), d = pk_bf16(y0 * dtl * dec, y1 * dtl * dec);
        xdtT[p0 * 72 + l] = (bf16_t)(a & 0xffffu); xdtT[(p0 + 1) * 72 + l] = (bf16_t)(a >> 16);
        xdecT[p0 * 72 + l] = (bf16_t)(d & 0xffffu); xdecT[(p0 + 1) * 72 + l] = (bf16_t)(d >> 16);
      }
      const int l = tid >> 2, s0 = (tid & 3) * 16;
      const float al = acs[l];
#pragma unroll
      for (int q = 0; q < 16; ++q) {
        const int s = s0 + q;
        const float v = (s <= l) ? bf2f(Gs[l * 72 + s]) * __expf(al - acs[s]) : 0.f;
        Ms[l * 72 + s] = f2bf(v);
      }
    }
    __syncthreads();
    {
      const float dsk = p.ev_d_skip[li * 16 + h];
      const int l = wave * 16 + fr;
      const float dskdt = dsk / fmaxf(dts[l], 1e-30f);
#pragma unroll
      for (int pb = 0; pb < 4; ++pb) {
        f32x4 d = mma_lds(xdtT + pb * 16 * 72, 72, Ms + wave * 16 * 72, 72, 64, fr, fq);
        const int pc = pb * 16 + fq * 4;
#pragma unroll
        for (int r = 0; r < 4; ++r) d[r] += dskdt * bf2f(xdtT[(pc + r) * 72 + l]);
#if DBG_SUB == 3
        if (hh > 100)
#endif
        { u32x2 yo; yo[0] = pk_bf16(d[0], d[1]); yo[1] = pk_bf16(d[2], d[3]); *(u32x2*)(YS + (size_t)(tok0 + l) * 1024 + grp * 512 + hh * 64 + pc) = yo; }
      }
#pragma unroll
      for (int nb = 0; nb < 8; ++nb) {
        const f32x4 d = mma_lds(BT + nb * 16 * 72, 72, xdecT + wave * 16 * 72, 72, 64, fr, fq);
        u32x2 sb; sb[0] = pk_bf16(d[0], d[1]); sb[1] = pk_bf16(d[2], d[3]);
        *(u32x2*)(ST + (((size_t)chunk * 16 + h) * 64 + wave * 16 + fr) * 128 + nb * 16 + fq * 4) = sb;
      }
    }
    __syncthreads();
  }
}

__device__ __forceinline__ void phase_scan(const Params& p) {
  unsigned* ST = (unsigned*)(p.ws + OFF_ST);
  const float* ACS = (const float*)(p.ws + OFF_ACS);
  for (int e2 = blockIdx.x * 256 + opaque_tid(); e2 < 16 * 64 * 128 / 2; e2 += gridDim.x * 256) {
    const int h = e2 >> 12;
    float c0 = 0.f, c1 = 0.f;
    for (int ch = 0; ch < NCHUNK; ch += 8) {
      unsigned sv[8]; float d[8];
#pragma unroll
      for (int j = 0; j < 8; ++j) { sv[j] = ST[(size_t)(ch + j) * 65536 + e2]; d[j] = ACS[(size_t)((ch + j) * 64 + 63) * 16 + h]; }
#pragma unroll
      for (int j = 0; j < 8; ++j) {
        ST[(size_t)(ch + j) * 65536 + e2] = pk_bf16(c0, c1);
        const float dec = __expf(d[j]);
        c0 = c0 * dec + bflo(sv[j]); c1 = c1 * dec + bfhi(sv[j]);
      }
    }
  }
}

__device__ __forceinline__ void ssd_out_item(const Params& p, int li, int chunk, int grp, int rh, char* smem) {
  const int tid = opaque_tid(), lane = tid & 63, wave = tid >> 6, fr = lane & 15, fq = lane >> 4;
  char* ws = p.ws;
  const bf16_t* H = (const bf16_t*)(ws + OFF_H);
  const float* ACS = (const float*)(ws + OFF_ACS);
  const bf16_t* CC = (const bf16_t*)(ws + OFF_CC);
  const bf16_t* YS = (const bf16_t*)(ws + OFF_YS);
  const bf16_t* ST = (const bf16_t*)(ws + OFF_ST);
  bf16_t* Y = (bf16_t*)(ws + OFF_Y);
  bf16_t* Cs = (bf16_t*)smem; bf16_t* Pv = (bf16_t*)(smem + 17408); float* rowss = (float*)(smem + 34816);
  const int tok0 = chunk * 64;
  __syncthreads();
#pragma unroll
  for (int i = 0; i < 4; ++i) {
    const int idx = tid + 256 * i, row = idx >> 4, ch = idx & 15;
    *(u32x4*)(Cs + row * 136 + ch * 8) = *(const u32x4*)(CC + (size_t)(tok0 + row) * 256 + grp * 128 + ch * 8);
  }
  if (tid < 64) rowss[tid] = 0.f;
  const int lb = rh * 2 + (wave & 1), pb0 = (wave >> 1) * 2;
  const int l = lb * 16 + fr;
  const size_t tok = (size_t)tok0 + l;
  float ss = 0.f;
  for (int hh = 0; hh < 8; ++hh) {
    const int h = grp * 8 + hh;
    __syncthreads();
    const bf16_t* src = ST + ((size_t)chunk * 16 + h) * 8192;
#pragma unroll
    for (int i = 0; i < 4; ++i) {
      const int idx = tid + 256 * i, row = idx >> 4, c8 = (idx & 15) * 8;
      *(u32x4*)(Pv + row * 136 + c8) = *(const u32x4*)(src + row * 128 + c8);
    }
    __syncthreads();
    const float ea = __expf(ACS[tok * 16 + h]);
#pragma unroll
    for (int pb = pb0; pb < pb0 + 2; ++pb) {
      const f32x4 d = mma_lds(Pv + pb * 16 * 136, 136, Cs + lb * 16 * 136, 136, 128, fr, fq);
      const int ch = grp * 512 + hh * 64 + pb * 16 + fq * 4;
      const u32x2 yi = *(const u32x2*)(YS + tok * 1024 + ch);
      f32x4 y = {bflo(yi[0]), bfhi(yi[0]), bflo(yi[1]), bfhi(yi[1])};
      const u32x2 z = *(const u32x2*)(H + tok * HS + 4096 + ch);
      y[0] = (y[0] + d[0] * ea) * silu_f(bflo(z[0])); y[1] = (y[1] + d[1] * ea) * silu_f(bfhi(z[0]));
      y[2] = (y[2] + d[2] * ea) * silu_f(bflo(z[1])); y[3] = (y[3] + d[3] * ea) * silu_f(bfhi(z[1]));
      { u32x2 yo; yo[0] = pk_bf16(y[0], y[1]); yo[1] = pk_bf16(y[2], y[3]); *(u32x2*)(Y + tok * D_ + 1024 + ch) = yo; }
      ss += y[0] * y[0] + y[1] * y[1] + y[2] * y[2] + y[3] * y[3];
    }
  }
  ss += __shfl_xor(ss, 16); ss += __shfl_xor(ss, 32);
  if (fq == 0) atomicAdd(&rowss[l], ss);
  __syncthreads();
  const float rs = rsqrtf(rowss[l] * (1.f / 512.f) + RMS_EPS);
  const float* ng = p.ev_ssm_norm_g + (size_t)li * 1024;
  for (int hh = 0; hh < 8; ++hh) {
#pragma unroll
    for (int pb = pb0; pb < pb0 + 2; ++pb) {
      const int ch = grp * 512 + hh * 64 + pb * 16 + fq * 4;
      const u32x2 yi = *(const u32x2*)(Y + tok * D_ + 1024 + ch);
      const f32x4 y = {bflo(yi[0]), bfhi(yi[0]), bflo(yi[1]), bfhi(yi[1])};
      const f32x4 g = *(const f32x4*)(ng + ch);
      u32x2 o; o[0] = pk_bf16(y[0] * rs * g[0], y[1] * rs * g[1]); o[1] = pk_bf16(y[2] * rs * g[2], y[3] * rs * g[3]);
      *(u32x2*)(Y + tok * D_ + 1024 + ch) = o;
    }
  }
}


#define XB_TMO      128
#define XB_XCNT(j)  (256  + 64 * (j))
#define XB_XSUB(j)  (1280 + 64 * (j))
#define XB_XGEN(j)  (2304 + 64 * (j))
#define XB_TOP      3328
#define XB_TOPGEN   3392
#define XCD_BAR_WORDS 3456
#define XB_SPIN_CAP (1u << 20)
#define LAS __attribute__((address_space(3)))
__device__ __forceinline__ unsigned xb_ld(unsigned* p)              { return __hip_atomic_load(p, __ATOMIC_RELAXED, __HIP_MEMORY_SCOPE_AGENT); }
__device__ __forceinline__ unsigned xb_add(unsigned* p, unsigned v) { return __hip_atomic_fetch_add(p, v, __ATOMIC_RELAXED, __HIP_MEMORY_SCOPE_AGENT); }
__device__ __forceinline__ unsigned xb_xcc_id() { return (unsigned)__builtin_amdgcn_s_getreg((3 << 11) | 20) & 0xFu; }
#define XB_SPIN(cond, bar) do { unsigned _sp = 0; while (cond) { __builtin_amdgcn_s_sleep(1); \
    if ((++_sp & 255u) == 0u) { if (xb_ld(&(bar)[XB_TMO])) break; if (_sp > XB_SPIN_CAP) { atomicAdd(&(bar)[XB_TMO], 1u); break; } } } } while (0)
struct XcdBarrier { unsigned* bar; unsigned x; volatile LAS unsigned* st; };
__device__ __forceinline__ XcdBarrier xcd_barrier_post(unsigned* bar, volatile LAS unsigned* st) {
    XcdBarrier b; b.bar = bar; b.x = xb_xcc_id(); b.st = st;
    if (threadIdx.x == 0) (void)xb_add(&bar[XB_XCNT(b.x)], 1u);
    return b;
}
__device__ __forceinline__ void xcd_barrier_complete(unsigned* bar, unsigned x, unsigned& nloc, unsigned& nx) {
    const unsigned G = gridDim.x * gridDim.y * gridDim.z;
    unsigned sum, cnt, mine, sp = 0u;
    for (;;) {
        sum = 0u; cnt = 0u; mine = 0u;
#pragma unroll
        for (unsigned j = 0; j < 16; ++j) { const unsigned c = xb_ld(&bar[XB_XCNT(j)]); sum += c; cnt += (c > 0u) ? 1u : 0u; mine = (j == x) ? c : mine; }
        if (sum == G) break;
        __builtin_amdgcn_s_sleep(1);
        if ((++sp & 255u) == 0u) { if (xb_ld(&bar[XB_TMO])) break; if (sp > XB_SPIN_CAP) { atomicAdd(&bar[XB_TMO], 1u); break; } }
    }
    nloc = mine > 0u ? mine : 1u; nx = cnt > 0u ? cnt : 1u;
}
__device__ __forceinline__ void xcd_barrier(const XcdBarrier& b) {
    asm volatile("s_waitcnt vmcnt(0)" ::: "memory");
    __syncthreads();
    if (threadIdx.x == 0) {
        unsigned* bar = b.bar;
        __builtin_amdgcn_s_waitcnt(0);
        unsigned nloc = b.st[0], nx = b.st[1];
        if (nloc == 0u) { xcd_barrier_complete(bar, b.x, nloc, nx); b.st[0] = nloc; b.st[1] = nx; }
        const unsigned old = xb_add(&bar[XB_XSUB(b.x)], 1u);
        const unsigned gen = old / nloc;
        if (old + 1u == (gen + 1u) * nloc) {
            __builtin_amdgcn_fence(__ATOMIC_RELEASE, "agent");
            asm volatile("s_waitcnt vmcnt(0)" ::: "memory");
            const unsigned og = xb_add(&bar[XB_TOP], 1u);
            const unsigned tg = og / nx;
            if (og + 1u == (tg + 1u) * nx) xb_add(&bar[XB_TOPGEN], 1u);
            else XB_SPIN(xb_ld(&bar[XB_TOPGEN]) == tg, bar);
            __builtin_amdgcn_fence(__ATOMIC_ACQUIRE, "agent");
            xb_add(&bar[XB_XGEN(b.x)], 1u);
            asm volatile("s_waitcnt vmcnt(0)" ::: "memory");
        } else {
            XB_SPIN(xb_ld(&bar[XB_XGEN(b.x)]) == gen, bar);
            __builtin_amdgcn_fence(__ATOMIC_ACQUIRE, "agent");
            asm volatile("s_waitcnt vmcnt(0)" ::: "memory");
        }
    }
    __syncthreads();
}

#define GSYNC_CG() do { asm volatile("s_waitcnt vmcnt(0)" ::: "memory"); grid.sync(); } while (0)
#define GSYNC() do { for (int rs_ = 0; rs_ < 1 + PROBE_SYNC; ++rs_) xcd_barrier(xb); } while (0)

#ifndef DBG_STOP
#define DBG_STOP 0
#endif
__device__ __forceinline__ void dbg_dump_bf16(float* out, const bf16_t* src) {
  for (size_t i = (size_t)blockIdx.x * 256 + threadIdx.x; i < (size_t)S_ * D_; i += (size_t)gridDim.x * 256) out[i] = bf2f(src[i]);
}
__global__ void __launch_bounds__(256, 2) fwd_megakernel(Params p) {
  extern __shared__ __attribute__((aligned(16))) char smem[];
  cg::grid_group grid = cg::this_grid();
  char* ws = p.ws;
  bf16_t* XB = (bf16_t*)(ws + OFF_XB);
  bf16_t* H = (bf16_t*)(ws + OFF_H);
  bf16_t* Y = (bf16_t*)(ws + OFF_Y);

  volatile LAS unsigned* xst = (volatile LAS unsigned*)(smem + LDS_BYTES);
  if (threadIdx.x == 0) { xst[0] = 0u; xst[1] = 0u; }
  __syncthreads();
  const XcdBarrier xb = xcd_barrier_post((unsigned*)(ws + OFF_BAR), xst);
  for (int rc_ = 0; rc_ < 1 + PROBE_CONV; ++rc_) phase_convert(p, smem);
  if (p.ws == nullptr) GSYNC_CG();
  GSYNC();
  if (DBG_STOP == 1) { dbg_dump_bf16(p.out, (const bf16_t*)(ws + OFF_WINE)); return; }

  for (int layer = 0; layer < 4; ++layer) {
    const int li = layer >> 1;
    const float* xprev = (layer == 0) ? p.x : p.out;
    if ((layer & 1) == 0) {
      {
        EpiEvenIn epi{H, (float*)(ws + OFF_DT)};
        for (int rep = 0; rep < 1 + PROBE_GEMM; ++rep)
        gemm_phase<false>(XB, D_, (const bf16_t*)(ws + OFF_WINE + (size_t)li * SZ_WINE), D_, S_, EINP, D_, epi, smem);
      }
      GSYNC();
      if (DBG_STOP == 2) { dbg_dump_bf16(p.out, H); return; }
      {
        float d1 = 0.f, d2 = 0.f;
        for (int j = 0; j < 64; ++j) { d1 += p.lq1[li * 64 + j] * p.lk1[li * 64 + j]; d2 += p.lq2[li * 64 + j] * p.lk2[li * 64 + j]; }
        const float lam_init = 0.8f - 0.6f * expf(-0.3f * (float)layer);
        const float lam = expf(d1) - expf(d2) + lam_init;
        const int nitem = 512 + 512;
        for (int rep2 = 0; rep2 < 1 + PROBE_B; ++rep2)
        for (int it = blockIdx.x; it < nitem; it += gridDim.x) {
          if (it < 512) {
            ssd_item(p, li, it >> 2, (it >> 1) & 1, (it & 1) * 4, smem);
          } else {
            const int pr = it - 512, head = pr & 7, c = pr >> 3;
#pragma unroll 1
            for (int rep = 0; rep < 2; ++rep) attn_item1(H, Y, p.subln_g + li * 128, lam, 1.f - lam_init, head, rep ? 127 - c : c, smem);
          }
        }
      }
      GSYNC();
      if (DBG_STOP == 3) {
        for (size_t i = (size_t)blockIdx.x * 256 + threadIdx.x; i < (size_t)S_ * 1024; i += (size_t)gridDim.x * 256) {
          const size_t r = i >> 10, c = i & 1023;
          p.out[r * D_ + c] = (DBG_SUB != 2) ? bf2f(Y[r * D_ + c]) : 0.f; { float yv = ((const float*)(ws + OFF_YS))[i]; if (!(fabsf(yv) < 1e30f)) yv = 12345.f; p.out[r * D_ + 1024 + c] = (DBG_SUB != 1) ? yv : 0.f; }
        }
        return;
      }
      if (DBG_STOP == 6) { for (size_t i = (size_t)blockIdx.x * 256 + threadIdx.x; i < (size_t)S_ * D_; i += (size_t)gridDim.x * 256) p.out[i] = ((const float*)(ws + OFF_ST))[i]; return; }
      phase_scan(p);
      GSYNC();
      for (int it = blockIdx.x; it < 512; it += gridDim.x) ssd_out_item(p, li, it >> 2, (it >> 1) & 1, it & 1, smem);
      GSYNC();
      if (DBG_STOP == 4) { dbg_dump_bf16(p.out, Y); return; }
      {
        EpiOut epi{p.x, layer ? (const float*)(ws + OFF_STATS) : nullptr, p.ln_g + (size_t)(layer ? layer - 1 : 0) * D_, p.ln_b + (size_t)(layer ? layer - 1 : 0) * D_, (bf16_t*)(ws + OFF_T)};
        gemm_phase<false>(Y, D_, (const bf16_t*)(ws + OFF_WOUTE + (size_t)li * SZ_W2K), D_, S_, D_, D_, epi, smem);
      }
    } else {
      {
        EpiOddIn epi{H};
        gemm_phase<false>(XB, D_, (const bf16_t*)(ws + OFF_WINO + (size_t)li * SZ_WINO), D_, S_, 4096, D_, epi, smem);
      }
      GSYNC();
      for (int rp_ = 0; rp_ < 1 + PROBE_CONV; ++rp_) phase_pool(H, (bf16_t*)(ws + OFF_POOL));
      GSYNC();
      {
        EpiGrp epi{H, p.od_b_grp + (size_t)li * 2048, p.od_scale + (size_t)li * 2048, Y};
        gemm_phase<true>((const bf16_t*)(ws + OFF_POOL), D_, (const bf16_t*)(ws + OFF_WGRP + (size_t)li * SZ_WGRP), 512, S_, D_, 512, epi, smem);
      }
      GSYNC();
      {
        EpiOut epi{p.x, layer ? (const float*)(ws + OFF_STATS) : nullptr, p.ln_g + (size_t)(layer ? layer - 1 : 0) * D_, p.ln_b + (size_t)(layer ? layer - 1 : 0) * D_, (bf16_t*)(ws + OFF_T)};
        gemm_phase<false>(Y, D_, (const bf16_t*)(ws + OFF_WOUTO + (size_t)li * SZ_W2K), D_, S_, D_, D_, epi, smem);
      }
    }
    GSYNC();
    phase_ln((const bf16_t*)(ws + OFF_T), p.out, XB, p.ln_g + (size_t)layer * D_, p.ln_b + (size_t)layer * D_, (float*)(ws + OFF_STATS), layer == 3);
    if (DBG_STOP == 5 && layer == 0) return;
    if (DBG_STOP == 7 && layer == 1) return;
    if (layer < 3) GSYNC();
  }
}

extern "C" void kernel_launch(void* const* d_in, const int* in_sizes, int n_in, void* d_out, int out_size, void* d_ws, size_t ws_size,
                              hipStream_t stream) {
  static int grid_blocks = 0;
  if (!grid_blocks) {
    int dev = 0, cus = 0, per_cu = 0;
    hipGetDevice(&dev);
    hipDeviceGetAttribute(&cus, hipDeviceAttributeMultiprocessorCount, dev);
    hipFuncSetAttribute((const void*)fwd_megakernel, hipFuncAttributeMaxDynamicSharedMemorySize, LDS_TOTAL);
    hipOccupancyMaxActiveBlocksPerMultiprocessor(&per_cu, fwd_megakernel, 256, LDS_TOTAL);
    if (per_cu > 2) per_cu = 2;
    if (per_cu < 1) per_cu = 1;
    grid_blocks = cus * per_cu;
  }
  if (ws_size < OFF_END2) { fprintf(stderr, "workspace too small: %zu < %zu\n", ws_size, (size_t)OFF_END); return; }
  Params p{};
  const float** pf = (const float**)&p;
  for (int i = 0; i < 21; ++i) pf[i] = (const float*)d_in[i];
  p.out = (float*)d_out; p.ws = (char*)d_ws;
  hipMemsetAsync((char*)d_ws + OFF_BAR, 0, XCD_BAR_WORDS * 4, stream);
  void* args[] = {&p};
  hipError_t e = hipLaunchCooperativeKernel((void*)fwd_megakernel, dim3(grid_blocks), dim3(256), args, LDS_TOTAL, stream);
  if (e != hipSuccess) fprintf(stderr, "cooperative launch failed: %s (grid %d)\n", hipGetErrorString(e), grid_blocks);
}
```
